# Optimizing an MI355X kernel written in HIP

```python
import math
import jax, jax.numpy as jnp
from jax import lax
import numpy as np

D_MODEL = 1024
BATCH = 4
SEQ = 8192
DEPTH = 2
DEC_BATCH = 2
DEC_SEQ = 16384
PAST_LEN = 128

GRID_W = 64
HEAD_DIM = 64
D_A = D_MODEL // 2
HYENA_ORDER = 2
HYENA_BANDS = 16
HYENA_EMB = 2 * HYENA_BANDS + 1
HYENA_FO = 64
HYENA_DECAY_MIN = math.log(100.0) / 1.5
HYENA_DECAY_MAX = math.log(100.0) / 0.3
H_B = D_MODEL // 4 // HEAD_DIM
D_B = H_B * HEAD_DIM
NA_KR = 8
NA_KC = 16
H_C = D_MODEL // 4 // HEAD_DIM
D_C = H_C * HEAD_DIM
DIL_PATTERNS = ((128, 1), (512, 4), (2048, 16))
ROPE_THETA = 10000.0
N_BRANCH = 3
IN_SPLITS = (3 * D_A, D_A, 3 * D_B, D_B, 3 * D_C, D_C, N_BRANCH * D_MODEL)
N_IN = sum(IN_SPLITS)
DEEPNORM_ALPHA = (2 * DEPTH) ** 0.25
DEEPNORM_BETA = (8 * DEPTH) ** -0.25
LN_EPS = 1e-5
NEG_INF = -1e30
F32 = jnp.float32

kernel_name = "hybrid_hyena_natten_dilated_encoder"


def _layernorm(x):
    xf = x.astype(F32)
    mu = jnp.mean(xf, -1, keepdims=True)
    var = jnp.mean(jnp.square(xf - mu), -1, keepdims=True)
    return (xf - mu) * lax.rsqrt(var + LN_EPS)


def _rope(x):
    L, dh = x.shape[1], x.shape[-1]
    half = dh // 2
    inv = ROPE_THETA ** (-jnp.arange(half, dtype=F32) / half)
    ang = jnp.arange(L, dtype=F32)[:, None] * inv[None, :]
    cos = jnp.cos(ang)[None, :, None, :]
    sin = jnp.sin(ang)[None, :, None, :]
    xf = x.astype(F32)
    x1, x2 = xf[..., :half], xf[..., half:]
    return jnp.concatenate([x1 * cos - x2 * sin, x2 * cos + x1 * sin], -1).astype(x.dtype)


def _hyena_spectrum(L, w1, b1, freq, w2, b2, w3, b3, decay):
    t = jnp.arange(L, dtype=F32) / L
    bands = jnp.arange(1, HYENA_BANDS + 1, dtype=F32)
    ang = 2.0 * math.pi * t[:, None] * bands[None, :]
    z = jnp.concatenate([t[:, None], jnp.cos(ang), jnp.sin(ang)], -1)
    freq = freq.astype(F32)
    h = jnp.sin(freq[0] * (z @ w1.astype(F32) + b1.astype(F32)))
    h = jnp.sin(freq[1] * (h @ w2.astype(F32) + b2.astype(F32)))
    h = (h @ w3.astype(F32) + b3.astype(F32)).reshape(L, 2, HYENA_ORDER, D_A)
    h = h * jnp.exp(-t[:, None, None, None] * jnp.abs(decay.astype(F32)))
    fwd, bwd = h[:, 0], h[:, 1]
    k = jnp.concatenate([fwd, jnp.zeros((1, HYENA_ORDER, D_A), F32), bwd[:0:-1]], 0)
    k = k / (jnp.sum(jnp.abs(k), 0, keepdims=True) + 1e-6)
    return jnp.fft.rfft(k, axis=0)


def _hyena(u, conv_w, conv_b, kf, skip):
    L = u.shape[1]
    up = jnp.pad(u, ((0, 0), (1, 1), (0, 0)))
    uc = up[:, :-2] * conv_w[0] + up[:, 1:-1] * conv_w[1] + up[:, 2:] * conv_w[2] + conv_b
    v, x1, x2 = jnp.split(uc.astype(F32), 3, axis=-1)
    z = v
    skip = skip.astype(F32)
    for o, xg in enumerate((x1, x2)):
        zf = jnp.fft.rfft(z, n=2 * L, axis=1)
        z = jnp.fft.irfft(zf * kf[:, o], n=2 * L, axis=1)[:, :L] + skip[o] * z
        z = xg * z
    return z.astype(u.dtype)


def _neighbourhood_attention(q, k, v, rpb):
    B, L, H, dh = q.shape
    rows = L // GRID_W
    kr = min(NA_KR, rows)
    r = jnp.arange(rows)
    c = jnp.arange(GRID_W)
    row_idx = jnp.clip(r - kr // 2, 0, rows - kr)[:, None] + jnp.arange(kr)[None, :]
    col_start = jnp.clip(c - NA_KC // 2, 0, GRID_W - NA_KC)
    col_ok = (c[None, :] >= col_start[:, None]) & (c[None, :] < col_start[:, None] + NA_KC)
    dr = row_idx - r[:, None] + NA_KR - 1
    dc = jnp.clip(c[None, :] - c[:, None], -(NA_KC - 1), NA_KC - 1) + NA_KC - 1
    bias = rpb[:, dr[:, None, :, None], dc[None, :, None, :]].astype(F32)
    qg = q.reshape(B, rows, GRID_W, H, dh)
    kg = k.reshape(B, rows, GRID_W, H, dh)[:, row_idx]
    vg = v.reshape(B, rows, GRID_W, H, dh)[:, row_idx]
    s = jnp.einsum('brqhd,brikhd->bhrqik', qg, kg, preferred_element_type=F32) * (dh ** -0.5)
    s = jnp.where(col_ok[:, None, :], s + bias[None], NEG_INF)
    p = jax.nn.softmax(s.reshape(B, H, rows, GRID_W, kr * GRID_W), -1).reshape(s.shape)
    o = jnp.einsum('bhrqik,brikhd->brqhd', p.astype(v.dtype), vg, preferred_element_type=F32)
    return o.reshape(B, L, H * dh).astype(q.dtype)


def _dilated_pattern(q, k, v, window, dilation):
    B, L, H, dh = q.shape
    blk = window // (2 * dilation)
    Ld = L // dilation
    nb = -(-Ld // blk)
    Lp = nb * blk

    def sub(x):
        x = x.reshape(B, Ld, dilation, H, dh)
        return jnp.pad(x, ((0, 0), (0, Lp - Ld), (0, 0), (0, 0), (0, 0)))

    def win(x):
        xb = jnp.pad(sub(x), ((0, 0), (blk, blk), (0, 0), (0, 0), (0, 0)))
        xb = xb.reshape(B, nb + 2, blk, dilation, H, dh)
        return jnp.concatenate([xb[:, :-2], xb[:, 1:-1], xb[:, 2:]], axis=2)

    qs = sub(q).reshape(B, nb, blk, dilation, H, dh)
    ks, vs = win(k), win(v)
    qi = jnp.arange(blk)
    ki = jnp.arange(3 * blk)
    kpos = (jnp.arange(nb)[:, None] - 1) * blk + ki[None, :]
    off = ki[None, :] - blk - qi[:, None]
    valid = (jnp.abs(off)[None] <= blk) & (kpos[:, None, :] >= 0) & (kpos[:, None, :] < Ld)
    s = jnp.einsum('bnqjhd,bnkjhd->bnjhqk', qs, ks, preferred_element_type=F32) * (dh ** -0.5)
    s = jnp.where(valid[None, :, None, None], s, NEG_INF)
    m = jnp.max(s, -1, keepdims=True)
    e = jnp.exp(s - m)
    l = jnp.sum(e, -1, keepdims=True)
    o = jnp.einsum('bnjhqk,bnkjhd->bnqjhd', (e / l).astype(v.dtype), vs, preferred_element_type=F32)
    lse = jnp.transpose((m + jnp.log(l))[..., 0], (0, 1, 4, 2, 3))
    o = o.reshape(B, Lp, dilation, H, dh)[:, :Ld].reshape(B, L, H, dh)
    lse = lse.reshape(B, Lp, dilation, H)[:, :Ld].reshape(B, L, H)
    return o, lse


def _dilated_mixture(q, k, v):
    B, L, H, dh = q.shape
    res = [_dilated_pattern(q, k, v, w, d) for (w, d) in DIL_PATTERNS]
    outs = jnp.stack([r[0] for r in res], 0)
    wts = jax.nn.softmax(jnp.stack([r[1] for r in res], 0), axis=0)
    o = jnp.sum(wts[..., None] * outs, 0)
    return o.reshape(B, L, H * dh).astype(q.dtype)


def _layer(x, c, l, w_ada, b_ada, w_in, b_in, hy_conv_w, hy_conv_b, hy_w1, hy_b1, hy_freq,
           hy_w2, hy_b2, hy_w3, hy_b3, hy_decay, hy_skip, na_rpb, w_branch_a, w_branch_b,
           w_branch_c, w_out, ln_g, ln_b):
    B, L, _ = x.shape
    ada = jax.nn.silu(c) @ w_ada[l] + b_ada[l]
    shift, scale, gate = jnp.split(ada, 3, axis=-1)
    h = (_layernorm(x) * (1.0 + scale[:, None]) + shift[:, None]).astype(x.dtype)
    proj = h @ w_in[l] + b_in[l]
    points = np.cumsum(IN_SPLITS)[:-1].tolist()
    a_in, a_z, b_qkv, b_z, c_qkv, c_z, g_all = jnp.split(proj, points, axis=-1)
    kf = _hyena_spectrum(L, hy_w1[l], hy_b1[l], hy_freq[l], hy_w2[l], hy_b2[l], hy_w3[l], hy_b3[l], hy_decay[l])
    y_a = _hyena(a_in, hy_conv_w[l], hy_conv_b[l], kf, hy_skip[l]) * jax.nn.silu(a_z)
    qb, kb, vb = [t.reshape(B, L, H_B, HEAD_DIM) for t in jnp.split(b_qkv, 3, axis=-1)]
    y_b = _neighbourhood_attention(qb, kb, vb, na_rpb[l]) * jax.nn.silu(b_z)
    qc, kc, vc = [t.reshape(B, L, H_C, HEAD_DIM) for t in jnp.split(c_qkv, 3, axis=-1)]
    y_c = _dilated_mixture(_rope(qc), _rope(kc), vc) * jax.nn.silu(c_z)
    g_a, g_b, g_c = jnp.split(jax.nn.sigmoid(g_all), 3, axis=-1)
    merged = g_a * (y_a @ w_branch_a[l]) + g_b * (y_b @ w_branch_b[l]) + g_c * (y_c @ w_branch_c[l])
    sub = (merged @ w_out[l]) * gate[:, None]
    res = DEEPNORM_ALPHA * x + sub
    return (_layernorm(res) * ln_g[l] + ln_b[l]).astype(x.dtype)


def setup_inputs(seed: int = 0) -> dict:
    key = jax.random.key(seed)
    ks = jax.random.split(key, 32)
    D = D_MODEL

    def nrm(k, shape, scale):
        return jax.random.normal(k, shape, F32) * scale

    return {
        "x_prompt": nrm(ks[0], (BATCH, SEQ, D), 1.0),
        "x_sample": nrm(ks[1], (DEC_BATCH, DEC_SEQ, D), 1.0),
        "c_prompt": nrm(ks[2], (BATCH, D), 1.0),
        "c_sample": nrm(ks[3], (DEC_BATCH, D), 1.0),
        "w_ada": nrm(ks[4], (DEPTH, D, 3 * D), D ** -0.5),
        "b_ada": nrm(ks[5], (DEPTH, 3 * D), 0.02),
        "w_in": nrm(ks[6], (DEPTH, D, N_IN), D ** -0.5),
        "b_in": nrm(ks[7], (DEPTH, N_IN), 0.02),
        "hy_conv_w": nrm(ks[8], (DEPTH, 3, 3 * D_A), 3 ** -0.5),
        "hy_conv_b": nrm(ks[9], (DEPTH, 3 * D_A), 0.02),
        "hy_w1": nrm(ks[10], (DEPTH, HYENA_EMB, HYENA_FO), HYENA_EMB ** -0.5),
        "hy_b1": nrm(ks[11], (DEPTH, HYENA_FO), 0.02),
        "hy_freq": 1.0 + nrm(ks[12], (DEPTH, 2, HYENA_FO), 0.1),
        "hy_w2": nrm(ks[13], (DEPTH, HYENA_FO, HYENA_FO), HYENA_FO ** -0.5),
        "hy_b2": nrm(ks[14], (DEPTH, HYENA_FO), 0.02),
        "hy_w3": nrm(ks[15], (DEPTH, HYENA_FO, 2 * HYENA_ORDER * D_A), HYENA_FO ** -0.5),
        "hy_b3": nrm(ks[16], (DEPTH, 2 * HYENA_ORDER * D_A), 0.02),
        "hy_decay": jax.random.uniform(ks[17], (DEPTH, D_A), F32, HYENA_DECAY_MIN, HYENA_DECAY_MAX),
        "hy_skip": nrm(ks[18], (DEPTH, HYENA_ORDER, D_A), 0.5),
        "na_rpb": nrm(ks[19], (DEPTH, H_B, 2 * NA_KR - 1, 2 * NA_KC - 1), 0.1),
        "w_branch_a": nrm(ks[20], (DEPTH, D_A, D), DEEPNORM_BETA * D_A ** -0.5),
        "w_branch_b": nrm(ks[21], (DEPTH, D_B, D), DEEPNORM_BETA * D_B ** -0.5),
        "w_branch_c": nrm(ks[22], (DEPTH, D_C, D), DEEPNORM_BETA * D_C ** -0.5),
        "w_out": nrm(ks[23], (DEPTH, D, D), DEEPNORM_BETA * D ** -0.5),
        "ln_g": 1.0 + nrm(ks[24], (DEPTH, D), 0.02),
        "ln_b": nrm(ks[25], (DEPTH, D), 0.02),
    }


def reference(x_prompt, x_sample, c_prompt, c_sample, w_ada, b_ada, w_in, b_in, hy_conv_w, hy_conv_b,
              hy_w1, hy_b1, hy_freq, hy_w2, hy_b2, hy_w3, hy_b3, hy_decay, hy_skip, na_rpb,
              w_branch_a, w_branch_b, w_branch_c, w_out, ln_g, ln_b):
    y_prompt, y_sample = x_prompt, x_sample
    for l in range(DEPTH):
        y_prompt = _layer(y_prompt, c_prompt, l, w_ada, b_ada, w_in, b_in, hy_conv_w, hy_conv_b,
                          hy_w1, hy_b1, hy_freq, hy_w2, hy_b2, hy_w3, hy_b3, hy_decay, hy_skip, na_rpb,
                          w_branch_a, w_branch_b, w_branch_c, w_out, ln_g, ln_b)
        y_sample = _layer(y_sample, c_sample, l, w_ada, b_ada, w_in, b_in, hy_conv_w, hy_conv_b,
                          hy_w1, hy_b1, hy_freq, hy_w2, hy_b2, hy_w3, hy_b3, hy_decay, hy_skip, na_rpb,
                          w_branch_a, w_branch_b, w_branch_c, w_out, ln_g, ln_b)
    return (y_prompt, y_sample)
```

```cpp
#include <hip/hip_runtime.h>
#include <hip/hip_cooperative_groups.h>
#include <cstdio>
namespace cg = cooperative_groups;

#define DEV __device__ __forceinline__
#define LAS __attribute__((address_space(3)))
typedef unsigned short bf16_t;
typedef short bf16x8 __attribute__((ext_vector_type(8)));
typedef float f32x4 __attribute__((ext_vector_type(4)));
typedef float v2f __attribute__((ext_vector_type(2)));
typedef unsigned u32x4 __attribute__((ext_vector_type(4)));
typedef unsigned u32x2 __attribute__((ext_vector_type(2)));

constexpr int NTHR = 512;
constexpr int DM = 1024, NIN = 7168, TCH = 16384, PLD = 5632;
constexpr int COL_AZ = 0, COL_BQ = 512, COL_BK = 768, COL_BV = 1024, COL_BZ = 1280, COL_CQ = 1536, COL_CK = 1792, COL_CV = 2048,
              COL_CZ = 2304, COL_GA = 2560, COL_GB = 3584, COL_GC = 4608;
constexpr size_t MiB = 1024 * 1024;
constexpr size_t OFF_H = 0, OFF_P = 32 * MiB, OFF_UT = 208 * MiB, OFF_YT = 256 * MiB, OFF_MG = OFF_UT, OFF_RES = OFF_UT, OFF_KF = 272 * MiB,
                 OFF_WIN = 400 * MiB, OFF_WA = 428 * MiB, OFF_WB = 430 * MiB, OFF_WC = 431 * MiB, OFF_WO = 432 * MiB,
                 OFF_ROPE = 436 * MiB, OFF_H2 = 440 * MiB, OFF_BIAS = 452 * MiB, OFF_ADA = OFF_BIAS + 64 * 1024,
                 OFF_CTR = OFF_ADA + 256 * 1024, OFF_DP = 456 * MiB, OFF_LSE = 504 * MiB, OFF_BAR = 505 * MiB, OFF_TW = 505 * MiB + 65536, OFF_W3T = 506 * MiB, WS_NEED = 507 * MiB;
constexpr int LDS_MAIN = 135168;
constexpr int LDS_TOTAL = LDS_MAIN + 1024;
constexpr float ALPHA_DN = 1.41421356237309515f;

struct Params {
  const float* x_prompt; const float* x_sample; const float* c_prompt; const float* c_sample;
  const float* w_ada; const float* b_ada; const float* w_in; const float* b_in;
  const float* hy_conv_w; const float* hy_conv_b; const float* hy_w1; const float* hy_b1; const float* hy_freq;
  const float* hy_w2; const float* hy_b2; const float* hy_w3; const float* hy_b3; const float* hy_decay; const float* hy_skip;
  const float* na_rpb; const float* w_br_a; const float* w_br_b; const float* w_br_c; const float* w_out;
  const float* ln_g; const float* ln_b;
  float* out; unsigned char* ws;
  int ph_begin, ph_end;
};

DEV int ltid() { int t = threadIdx.x; asm volatile("" : "+v"(t)); return t; }
typedef _Float16 h16x2 __attribute__((ext_vector_type(2)));
typedef _Float16 h16x8 __attribute__((ext_vector_type(8)));
DEV float bf2f(bf16_t b) { return (float)__builtin_bit_cast(_Float16, b); }
DEV float bflo(unsigned w) { return (float)__builtin_bit_cast(h16x2, w)[0]; }
DEV float bfhi(unsigned w) { return (float)__builtin_bit_cast(h16x2, w)[1]; }
DEV bf16_t f2bf(float f) { return __builtin_bit_cast(bf16_t, (_Float16)f); }
DEV unsigned pk2(float lo, float hi) { h16x2 v; v[0] = (_Float16)lo; v[1] = (_Float16)hi; return __builtin_bit_cast(unsigned, v); }
#define MFMA16(a, b, c) __builtin_amdgcn_mfma_f32_16x16x32_f16(__builtin_bit_cast(h16x8, (a)), __builtin_bit_cast(h16x8, (b)), (c), 0, 0, 0)
DEV float sigmoidf_(float x) { return __builtin_amdgcn_rcpf(1.0f + __expf(-x)); }
DEV float siluf_(float x) { return x * __builtin_amdgcn_rcpf(1.0f + __expf(-x)); }

DEV float wave_sum(float v) {
#pragma unroll
  for (int m = 32; m >= 1; m >>= 1) v += __shfl_xor(v, m);
  return v;
}
DEV float block_sum(float v, LAS float* red) {
  v = wave_sum(v);
  __syncthreads();
  { const int t_ = ltid(); if ((t_ & 63) == 0) red[t_ >> 6] = v; }
  __syncthreads();
  float s = 0.f;
#pragma unroll
  for (int i = 0; i < NTHR / 64; ++i) s += red[i];
  return s;
}

#define LDSF2 LAS v2f
#define SYNC() __syncthreads()
#define SINCOS_TAB(idx, c, s) do { const float f_ = (float)(idx) * (1.0f / 32768.0f); c = __builtin_amdgcn_cosf(f_); s = __builtin_amdgcn_sinf(f_); } while (0)
#define BREV32(v) __brev(v)
#ifndef MULTI_LAUNCH
#define MULTI_LAUNCH 0
#endif
DEV int PIDX(int i) { return i + (i >> 5); }

DEV void w16(int m, float& c, float& s) {
  const float K = 0.70710678118654752f, C1 = 0.92387953251128674f, S1 = 0.38268343236508977f;
  switch (m & 7) {
    case 0: c = 1.f; s = 0.f; break;
    case 1: c = C1; s = -S1; break;
    case 2: c = K; s = -K; break;
    case 3: c = S1; s = -C1; break;
    case 4: c = 0.f; s = -1.f; break;
    case 5: c = -S1; s = -C1; break;
    case 6: c = -K; s = -K; break;
    default: c = -C1; s = -S1; break;
  }
}

template <int R>
DEV void dif_group(float (&xr)[R], float (&xi)[R], float wr, float wi) {
#pragma unroll
  for (int Ra = R; Ra >= 2; Ra >>= 1) {
    const int half = Ra >> 1;
#pragma unroll
    for (int q = 0; q < R; ++q) {
      const int p = q & (Ra - 1);
      if (p < half) {
        const int q2 = q + half;
        const float ar = xr[q], ai = xi[q], br = xr[q2], bi = xi[q2];
        xr[q] = ar + br; xi[q] = ai + bi;
        const float dr = ar - br, di = ai - bi;
        float c, s; w16(p * (16 / Ra), c, s);
        const float tr = wr * c - wi * s, ti = wr * s + wi * c;
        xr[q2] = dr * tr - di * ti; xi[q2] = dr * ti + di * tr;
      }
    }
    const float nr = wr * wr - wi * wi, ni = 2.f * wr * wi; wr = nr; wi = ni;
  }
}

template <int R>
DEV void dit_group_inv(float (&xr)[R], float (&xi)[R], float wr, float wi) {
  float war[4], wai[4];
  war[0] = wr; wai[0] = wi;
#pragma unroll
  for (int a = 1; a < 4; ++a) { war[a] = war[a - 1] * war[a - 1] - wai[a - 1] * wai[a - 1]; wai[a] = 2.f * war[a - 1] * wai[a - 1]; }
#pragma unroll
  for (int Ra = 2; Ra <= R; Ra <<= 1) {
    const int half = Ra >> 1;
    const int a = (Ra == R) ? 0 : ((Ra * 2 == R) ? 1 : ((Ra * 4 == R) ? 2 : 3));
#pragma unroll
    for (int q = 0; q < R; ++q) {
      const int p = q & (Ra - 1);
      if (p < half) {
        const int q2 = q + half;
        float c, s; w16(p * (16 / Ra), c, s);
        const float tr = war[a] * c - wai[a] * s, ti = war[a] * s + wai[a] * c;
        const float br = xr[q2] * tr + xi[q2] * ti, bi = xi[q2] * tr - xr[q2] * ti;
        const float ar = xr[q], ai = xi[q];
        xr[q] = ar + br; xi[q] = ai + bi;
        xr[q2] = ar - br; xi[q2] = ai - bi;
      }
    }
  }
}

template <int R, bool INV, bool ZHI = false, bool LOH = false>
DEV void fft_pass(LDSF2* x, int N, int S, int tid, int nthr, const v2f* TW) {
  const int Q = S / R;
  const int logQ = __builtin_ctz((unsigned)Q);
  const int ngroups = N / R;
#pragma unroll 2
  for (int g = tid; g < ngroups; g += nthr) {
    const int blk = g >> logQ, j = g & (Q - 1);
    const int base = blk * S + j;
    float xr[R], xi[R];
#pragma unroll
    for (int q = 0; q < R; ++q) { if (ZHI && q >= R / 2) { xr[q] = 0.f; xi[q] = 0.f; } else { const v2f v = x[PIDX(base + q * Q)]; xr[q] = v.x; xi[q] = v.y; } }
    float c, s; SINCOS_TAB(j * (32768 / S), c, s);
    if (INV) dit_group_inv<R>(xr, xi, c, -s); else dif_group<R>(xr, xi, c, -s);
#pragma unroll
    for (int q = 0; q < R; ++q) { if (LOH && q >= R / 2) continue; v2f v; v.x = xr[q]; v.y = xi[q]; x[PIDX(base + q * Q)] = v; }
  }
}

template <bool ZHI = false>
DEV void fft_fwd(LDSF2* x, int N, int tid, int nthr, const v2f* TW) {
  int S = N;
  if (ZHI) { fft_pass<16, false, true>(x, N, S, tid, nthr, TW); SYNC(); S >>= 4; }
  while (S >= 16) { fft_pass<16, false>(x, N, S, tid, nthr, TW); SYNC(); S >>= 4; }
  if (S == 8) { fft_pass<8, false>(x, N, 8, tid, nthr, TW); SYNC(); }
  else if (S == 4) { fft_pass<4, false>(x, N, 4, tid, nthr, TW); SYNC(); }
  else if (S == 2) { fft_pass<2, false>(x, N, 2, tid, nthr, TW); SYNC(); }
}
template <bool LOH = false>
DEV void fft_inv(LDSF2* x, int N, int tid, int nthr, const v2f* TW) {
  int rem = N; while (rem >= 16) rem >>= 4;
  int S = 1;
  if (rem == 8) { fft_pass<8, true>(x, N, 8, tid, nthr, TW); SYNC(); S = 8; }
  else if (rem == 4) { fft_pass<4, true>(x, N, 4, tid, nthr, TW); SYNC(); S = 4; }
  else if (rem == 2) { fft_pass<2, true>(x, N, 2, tid, nthr, TW); SYNC(); S = 2; }
  while (S < N) { S <<= 4; if (LOH && S == N) fft_pass<16, true, false, true>(x, N, S, tid, nthr, TW); else fft_pass<16, true>(x, N, S, tid, nthr, TW); SYNC(); }
}

DEV void spec_mul(LDSF2* x, int N, int logN, const v2f* Kf, int tid, int nthr, const v2f* TW) {
  const int twm = 16384 / N;
  for (int k = tid; k <= N / 2; k += nthr) {
    if (k == 0) {
      const v2f c = x[PIDX(0)]; const v2f kk = Kf[0];
      const float Y0 = (c.x + c.y) * kk.x, YN = (c.x - c.y) * kk.y;
      v2f d; d.x = 0.5f * (Y0 + YN); d.y = 0.5f * (Y0 - YN); x[PIDX(0)] = d;
    } else if (k == N / 2) {
      const v2f c = x[PIDX(1)]; const v2f kk = Kf[N / 2];
      const float yr = c.x * kk.x + c.y * kk.y, yi = c.x * kk.y - c.y * kk.x;
      v2f d; d.x = yr; d.y = -yi; x[PIDX(1)] = d;
    } else {
      const int p1 = PIDX((int)(BREV32((unsigned)k) >> (32 - logN)));
      const int p2 = PIDX((int)(BREV32((unsigned)(N - k)) >> (32 - logN)));
      const v2f c1 = x[p1], c2 = x[p2];
      const v2f k1 = Kf[k], k2 = Kf[N - k];
      const float er = 0.5f * (c1.x + c2.x), ei = 0.5f * (c1.y - c2.y);
      const float fr = 0.5f * (c1.x - c2.x), fi = 0.5f * (c1.y + c2.y);
      const float orr = fi, oi = -fr;
      float wc, ws; SINCOS_TAB(k * twm, wc, ws);
      const float wr = wc, wi = -ws;
      const float tr = wr * orr - wi * oi, ti = wr * oi + wi * orr;
      const float x1r = er + tr, x1i = ei + ti;
      const float x2r = er - tr, x2i = -(ei - ti);
      const float y1r = x1r * k1.x - x1i * k1.y, y1i = x1r * k1.y + x1i * k1.x;
      const float y2r = x2r * k2.x - x2i * k2.y, y2i = x2r * k2.y + x2i * k2.x;
      const float yer = 0.5f * (y1r + y2r), yei = 0.5f * (y1i - y2i);
      const float gr = 0.5f * (y1r - y2r), gi = 0.5f * (y1i + y2i);
      const float yor = gr * wr + gi * wi, yoi = gi * wr - gr * wi;
      v2f d1, d2;
      d1.x = yer - yoi; d1.y = yei + yor;
      d2.x = yer + yoi; d2.y = -yei + yor;
      x[p1] = d1; x[p2] = d2;
    }
  }
}

DEV void spec_unpack(const LDSF2* x, int N, int logN, v2f* Kf, float scale, float add, int tid, int nthr, const v2f* TW) {
  const int twm = 16384 / N;
  for (int k = tid; k <= N / 2; k += nthr) {
    if (k == 0) {
      const v2f c = x[PIDX(0)];
      v2f o; o.x = (c.x + c.y) * scale + add; o.y = (c.x - c.y) * scale + add; Kf[0] = o;
    } else if (k == N / 2) {
      const v2f c = x[PIDX(1)];
      v2f o; o.x = c.x * scale + add; o.y = -c.y * scale; Kf[N / 2] = o;
    } else {
      const int p1 = PIDX((int)(BREV32((unsigned)k) >> (32 - logN)));
      const int p2 = PIDX((int)(BREV32((unsigned)(N - k)) >> (32 - logN)));
      const v2f c1 = x[p1], c2 = x[p2];
      const float er = 0.5f * (c1.x + c2.x), ei = 0.5f * (c1.y - c2.y);
      const float fr = 0.5f * (c1.x - c2.x), fi = 0.5f * (c1.y + c2.y);
      const float orr = fi, oi = -fr;
      float wc, ws; SINCOS_TAB(k * twm, wc, ws);
      const float wr = wc, wi = -ws;
      const float tr = wr * orr - wi * oi, ti = wr * oi + wi * orr;
      v2f o1, o2;
      o1.x = (er + tr) * scale + add; o1.y = (ei + ti) * scale;
      o2.x = (er - tr) * scale + add; o2.y = -(ei - ti) * scale;
      Kf[k] = o1; Kf[N - k] = o2;
    }
  }
}
#ifndef SUB
#define SUB -1
#endif
#define SEN(k) (SUB < 0 || SUB == (k))

namespace pg8 {
constexpr int BM = 256, BK = 64, HALF = 128, HTB = HALF * BK * 2, STAGE_BYTES = 8 * HTB, NXCD = 8, WGM = 8;
DEV int lds_byte(int r, int c) { const int st = (r >> 4) * 2 + (c >> 5), rr = r & 15, cc = c & 31, ob = rr * 64 + cc * 2; return st * 1024 + (ob ^ (((ob >> 9) & 1) << 5)); }
DEV void stage_rc(int b, int& R, int& C) { const int st = b / 1024, sb = b % 1024, swz = sb ^ (((sb >> 9) & 1) << 5); R = (st >> 1) * 16 + swz / 64; C = (st & 1) * 32 + (swz % 64) / 2; }
struct Unit { int pm, pn, seg; };
struct Gemm { const bf16_t* A; const bf16_t* Bt; int lda, ldb, M, N, K; };
struct StaticOrder {
  int nM, nN, nwg, G, c;
  DEV void init(int M, int N, int G_, int c_) { nM = M / BM; nN = N / BM; nwg = nM * nN; G = G_; c = c_; }
  DEV bool next(int i, Unit& u) const {
    const long L = (long)i * G + c; if (L >= nwg) return false;
    int wgid = (int)L; { const int q = nwg / NXCD, r = nwg % NXCD, xcd = wgid % NXCD, off = wgid / NXCD; wgid = (xcd < r ? xcd * (q + 1) : r * (q + 1) + (xcd - r) * q) + off; }
    const int nig = WGM * nN, gid = wgid / nig, fm = gid * WGM, gsz = (nM - fm) < WGM ? (nM - fm) : WGM;
    u.pm = fm + ((wgid % nig) % gsz); u.pn = (wgid % nig) / gsz; return true;
  }
};
struct PlainSched {
  StaticOrder so; const char* A; const char* B; size_t tstepA, tstepB; int ntv;
  DEV void init(const Gemm& g, int G, int c) { so.init(g.M, g.N, G, c); A = (const char*)g.A; B = (const char*)g.Bt; tstepA = (size_t)BM * g.lda * 2; tstepB = (size_t)BM * g.ldb * 2; ntv = g.K / BK; }
  DEV bool next(int i, Unit& u) const { u.seg = 0; return so.next(i, u); }
  DEV const char* aptr(const Unit& u) const { return A + (size_t)u.pm * tstepA; }
  DEV const char* bptr(const Unit& u) const { return B + (size_t)u.pn * tstepB; }
  DEV int nt(const Unit&) const { return ntv; }
};
struct BranchSched {
  StaticOrder so; const char* A; const char* B; size_t tstepA, tstepB;
  DEV void init(const bf16_t* P, const bf16_t* W, int G, int c) { so.init(TCH, DM, G, c); A = (const char*)P; B = (const char*)W; tstepA = (size_t)BM * PLD * 2; tstepB = (size_t)BM * DM * 2; }
  DEV bool next(int i, Unit& u) const { const int ui = i / 3; if (!so.next(ui, u)) return false; u.seg = i - ui * 3; return true; }
  DEV const char* aptr(const Unit& u) const { const int col = (u.seg == 0) ? COL_AZ : ((u.seg == 1) ? COL_BZ : COL_CZ); return A + (size_t)u.pm * tstepA + col * 2; }
  DEV const char* bptr(const Unit& u) const { const int ko = (u.seg == 0) ? 0 : ((u.seg == 1) ? 512 : 768); return B + (size_t)u.pn * tstepB + ko * 2; }
  DEV int nt(const Unit& u) const { return (u.seg == 0) ? 8 : 4; }
};
template <class Epi, class Sched>
DEV void gemm_phase(LAS unsigned char* lds, const int lda, const int ldb, const Sched& S, const Epi& E) {
  const int tid = ltid(), wid = __builtin_amdgcn_readfirstlane(tid >> 6), lane = tid & 63, wr = wid >> 2, wc = wid & 3, fr = lane & 15, fq = lane >> 4;
  unsigned voffA[2], voffB[2];
#pragma unroll
  for (int i = 0; i < 2; ++i) { int R, C; stage_rc(tid * 16 + i * 8192, R, C);
    voffA[i] = (unsigned)(R * lda + C) * 2u; voffB[i] = (unsigned)(R * ldb + C) * 2u; }
  const size_t kstep = (size_t)(BK * 2);
  const size_t hstepA = (size_t)HALF * lda * 2, hstepB = (size_t)HALF * ldb * 2;
  const unsigned ldsw = (unsigned)wid * 1024u;
  const int aoff = lds_byte(wr * 64 + fr, fq * 8), boff = lds_byte(wc * 32 + fr, fq * 8);
#define PG8_SA(b, h) (((b) * 2 + (h)) * HTB)
#define PG8_SB(b, h) ((4 + (b) * 2 + (h)) * HTB)
#define PG8_STAGE(bufoff, gbase, voff) do { _Pragma("unroll") for (int _i = 0; _i < 2; ++_i) \
        __builtin_amdgcn_global_load_lds((const unsigned*)((const char*)(gbase) + (voff)[_i]), (LAS unsigned*)(lds + (bufoff) + ldsw + _i * 8192), 16, 0, 0); } while (0)
#define PG8_LDA(dst, b, h) do { _Pragma("unroll") for (int m = 0; m < 4; ++m) _Pragma("unroll") for (int k = 0; k < 2; ++k) dst[m][k] = *(const LAS bf16x8*)(lds + PG8_SA(b, h) + aoff + m * 2048 + k * 1024); } while (0)
#define PG8_LDB(dst, b, h) do { _Pragma("unroll") for (int n = 0; n < 2; ++n) _Pragma("unroll") for (int k = 0; k < 2; ++k) dst[n][k] = *(const LAS bf16x8*)(lds + PG8_SB(b, h) + boff + n * 2048 + k * 1024); } while (0)
#define PG8_MMA(ai, bj, At, Bt) do { __builtin_amdgcn_s_setprio(1); _Pragma("unroll") for (int m = 0; m < 4; ++m) _Pragma("unroll") for (int n = 0; n < 2; ++n) _Pragma("unroll") for (int k = 0; k < 2; ++k) \
        acc[ai][bj][m][n] = MFMA16(Bt[n][k], At[m][k], acc[ai][bj][m][n]); __builtin_amdgcn_s_setprio(0); } while (0)
#define PG8_WAIT_V(n) asm volatile("s_waitcnt vmcnt(" #n ")" ::: "memory")
#define PG8_WAIT_L(n) asm volatile("s_waitcnt lgkmcnt(" #n ")" ::: "memory")
#define PG8_BAR __builtin_amdgcn_s_barrier()
#define PG8_SCHED __builtin_amdgcn_sched_barrier(0)
  Unit cur, nxt; int ui = 0;
  if (!S.next(0, cur)) return;
  f32x4 acc[2][2][4][2];
#pragma unroll
  for (int a = 0; a < 2; ++a)
#pragma unroll
    for (int b = 0; b < 2; ++b)
#pragma unroll
      for (int m = 0; m < 4; ++m)
#pragma unroll
        for (int n = 0; n < 2; ++n) acc[a][b][m][n] = (f32x4){0.f, 0.f, 0.f, 0.f};
  bf16x8 At[4][2], B0[2][2], B1[2][2];
  const char* cA = S.aptr(cur); const char* cB = S.bptr(cur);
  int nt = S.nt(cur); asm volatile("" : "+s"(nt));
  PG8_STAGE(PG8_SB(0, 0), cB, voffB); PG8_STAGE(PG8_SA(0, 0), cA, voffA); PG8_STAGE(PG8_SB(0, 1), cB + hstepB, voffB); PG8_STAGE(PG8_SA(0, 1), cA + hstepA, voffA);
  if (wr == 1) PG8_BAR;
  PG8_WAIT_V(4); PG8_BAR;
  PG8_STAGE(PG8_SB(1, 0), cB + kstep, voffB); PG8_STAGE(PG8_SA(1, 0), cA + kstep, voffA); PG8_STAGE(PG8_SB(1, 1), cB + hstepB + kstep, voffB);
  PG8_WAIT_V(6); PG8_BAR;
  for (;;) {
    const bool has_next = S.next(ui + 1, nxt);
    const char* nA = has_next ? S.aptr(nxt) : cA; const char* nB = has_next ? S.bptr(nxt) : cB;
#pragma unroll 1
    for (int t = 0; t < nt; t += 2) {
      const bool last = (t == nt - 2);
      const char* a1 = cA + (size_t)(t + 1) * kstep;
      const char* a2 = last ? nA : cA + (size_t)(t + 2) * kstep; const char* b2 = last ? nB : cB + (size_t)(t + 2) * kstep;
      const char* a3 = a2 + kstep; const char* b3 = b2 + kstep;
      PG8_LDB(B0, 0, 0); PG8_SCHED; PG8_LDA(At, 0, 0); PG8_STAGE(PG8_SA(1, 1), a1 + hstepA, voffA);
      PG8_WAIT_L(8); PG8_BAR; PG8_WAIT_L(0); PG8_MMA(0, 0, At, B0); PG8_BAR; PG8_SCHED;
      PG8_LDB(B1, 0, 1); PG8_STAGE(PG8_SB(0, 0), b2, voffB);
      PG8_BAR; PG8_WAIT_L(0); PG8_MMA(0, 1, At, B1); PG8_BAR;
      PG8_LDA(At, 0, 1); PG8_STAGE(PG8_SA(0, 0), a2, voffA);
      PG8_BAR; PG8_WAIT_L(0); PG8_MMA(1, 0, At, B0); PG8_BAR; PG8_SCHED;
      PG8_STAGE(PG8_SB(0, 1), b2 + hstepB, voffB);
      PG8_WAIT_V(6); PG8_BAR; PG8_MMA(1, 1, At, B1); PG8_BAR;
      PG8_LDB(B0, 1, 0); PG8_SCHED; PG8_LDA(At, 1, 0); PG8_STAGE(PG8_SA(0, 1), a2 + hstepA, voffA);
      PG8_WAIT_L(8); PG8_BAR; PG8_WAIT_L(0); PG8_MMA(0, 0, At, B0); PG8_BAR; PG8_SCHED;
      PG8_LDB(B1, 1, 1); PG8_STAGE(PG8_SB(1, 0), b3, voffB);
      PG8_BAR; PG8_WAIT_L(0); PG8_MMA(0, 1, At, B1); PG8_BAR;
      PG8_LDA(At, 1, 1); PG8_STAGE(PG8_SA(1, 0), a3, voffA);
      PG8_BAR; PG8_WAIT_L(0); PG8_MMA(1, 0, At, B0); PG8_BAR; PG8_SCHED;
      PG8_STAGE(PG8_SB(1, 1), b3 + hstepB, voffB);
      PG8_WAIT_V(6); PG8_BAR; PG8_MMA(1, 1, At, B1); PG8_BAR;
    }
    const bool zero_after = E(acc, cur, wr, wc, fr, fq);
    if (!has_next) break;
    if (zero_after)
#pragma unroll
    for (int a = 0; a < 2; ++a)
#pragma unroll
      for (int b = 0; b < 2; ++b)
#pragma unroll
        for (int m = 0; m < 4; ++m)
#pragma unroll
          for (int n = 0; n < 2; ++n) acc[a][b][m][n] = (f32x4){0.f, 0.f, 0.f, 0.f};
    cur = nxt; cA = nA; cB = nB; ++ui; nt = S.nt(cur); asm volatile("" : "+s"(nt));
  }
  PG8_WAIT_V(0);
  if (wr == 0) PG8_BAR;
  PG8_BAR;
#undef PG8_SA
#undef PG8_SB
#undef PG8_STAGE
#undef PG8_LDA
#undef PG8_LDB
#undef PG8_MMA
#undef PG8_WAIT_V
#undef PG8_WAIT_L
#undef PG8_BAR
#undef PG8_SCHED
}
}

typedef f32x4 (&AccRef)[2][2][4][2];

struct EpiIn {
  const float* bias;
  bf16_t* UT; bf16_t* P; const f32x4* rope;
  int L;
  DEV bool operator()(AccRef acc, const pg8::Unit& u, int wr, int wc, int fr, int fq) const {
    const int pn = u.pn;
    const int row0 = u.pm * 256 + wr * 64 + fr;
    const int cl0 = wc * 32 + 4 * fq;
    if (pn < 6) {
#pragma unroll
      for (int bj = 0; bj < 2; ++bj)
#pragma unroll
        for (int n = 0; n < 2; ++n) {
          const int c0 = pn * 256 + bj * 128 + n * 16 + cl0;
          const f32x4 bv = *(const f32x4*)(bias + c0);
#pragma unroll
          for (int ai = 0; ai < 2; ++ai)
#pragma unroll
            for (int m = 0; m < 4; ++m) {
              const int row = row0 + ai * 128 + m * 16;
              const f32x4 v = acc[ai][bj][m][n] + bv;
              bf16_t* d = UT + (size_t)c0 * TCH + row;
              d[0] = f2bf(v[0]); d[TCH] = f2bf(v[1]); d[2 * TCH] = f2bf(v[2]); d[3 * TCH] = f2bf(v[3]);
            }
        }
      return true;
    }
    int mode = 0;
    if (pn == 6 || pn == 7 || pn == 11 || pn == 15) mode = 1; else if (pn >= 16) mode = 2; else if (pn == 12 || pn == 13) mode = 3;
#pragma unroll
    for (int bj = 0; bj < 2; ++bj)
#pragma unroll
      for (int n = 0; n < 2; ++n) {
        const int c0 = pn * 256 + bj * 128 + n * 16 + cl0;
        const int pc0 = c0 - 1536;
        const f32x4 bv = *(const f32x4*)(bias + c0);
#pragma unroll
        for (int ai = 0; ai < 2; ++ai)
#pragma unroll
          for (int m = 0; m < 4; ++m) {
            const int row = row0 + ai * 128 + m * 16;
            f32x4 v = acc[ai][bj][m][n] + bv;
            if (mode == 1) { v[0] = siluf_(v[0]); v[1] = siluf_(v[1]); v[2] = siluf_(v[2]); v[3] = siluf_(v[3]); }
            else if (mode == 2) { v[0] = sigmoidf_(v[0]); v[1] = sigmoidf_(v[1]); v[2] = sigmoidf_(v[2]); v[3] = sigmoidf_(v[3]); }
            else if (mode == 3) {
              const int pos = row & (L - 1);
              const f32x4 cs = rope[(size_t)pos * 16 + ((c0 & 63) >> 2)];
              const float a0 = v[0] * cs[0] - v[1] * cs[1], a1 = v[1] * cs[0] + v[0] * cs[1];
              const float a2 = v[2] * cs[2] - v[3] * cs[3], a3 = v[3] * cs[2] + v[2] * cs[3];
              v[0] = a0; v[1] = a1; v[2] = a2; v[3] = a3;
            }
            u32x2 o; o[0] = pk2(v[0], v[1]); o[1] = pk2(v[2], v[3]);
            *(u32x2*)(P + (size_t)row * PLD + pc0) = o;
          }
      }
    return true;
  }
};
struct EpiBranch {
  const bf16_t* P; bf16_t* Mout;
  DEV bool operator()(AccRef acc, const pg8::Unit& u, int wr, int wc, int fr, int fq) const {
    const int row0 = u.pm * 256 + wr * 64 + fr;
    const int seg = u.seg;
    const int numc = (seg == 0) ? COL_GA : ((seg == 1) ? COL_GB : COL_GC);
    const int denc = (seg == 0) ? COL_GB : COL_GC;
#pragma unroll
    for (int bj = 0; bj < 2; ++bj)
#pragma unroll
      for (int n = 0; n < 2; ++n) {
        const int c0 = u.pn * 256 + bj * 128 + n * 16 + wc * 32 + 4 * fq;
#pragma unroll
        for (int ai = 0; ai < 2; ++ai)
#pragma unroll
          for (int m = 0; m < 4; ++m) {
            const int row = row0 + ai * 128 + m * 16;
            const bf16_t* pr = P + (size_t)row * PLD + c0;
            const u32x2 gn = *(const u32x2*)(pr + numc);
            f32x4 v = acc[ai][bj][m][n];
            const float lo_ = (seg == 0) ? 0.0f : 1e-30f;
            const float n0 = fmaxf(bflo(gn[0]), lo_), n1 = fmaxf(bfhi(gn[0]), lo_), n2 = fmaxf(bflo(gn[1]), lo_), n3 = fmaxf(bfhi(gn[1]), lo_);
            if (seg < 2) {
              const u32x2 gd = *(const u32x2*)(pr + denc);
              v[0] *= n0 * __builtin_amdgcn_rcpf(fmaxf(bflo(gd[0]), 1e-30f)); v[1] *= n1 * __builtin_amdgcn_rcpf(fmaxf(bfhi(gd[0]), 1e-30f));
              v[2] *= n2 * __builtin_amdgcn_rcpf(fmaxf(bflo(gd[1]), 1e-30f)); v[3] *= n3 * __builtin_amdgcn_rcpf(fmaxf(bfhi(gd[1]), 1e-30f));
              acc[ai][bj][m][n] = v;
            } else {
              v[0] *= n0; v[1] *= n1; v[2] *= n2; v[3] *= n3;
              u32x2 o; o[0] = pk2(v[0], v[1]); o[1] = pk2(v[2], v[3]); *(u32x2*)(Mout + (size_t)row * DM + c0) = o;
            }
          }
      }
    return seg == 2;
  }
};
struct EpiOut {
  const float* xin; bf16_t* res16; const float* ada_l;
  int bbase, L;
  DEV bool operator()(AccRef acc, const pg8::Unit& u, int wr, int wc, int fr, int fq) const {
    const int row0 = u.pm * 256 + wr * 64 + fr;
    const int b = bbase + (u.pm * 256) / L;
    const float* gate = ada_l + b * 3072 + 2048;
#pragma unroll
    for (int bj = 0; bj < 2; ++bj)
#pragma unroll
      for (int n = 0; n < 2; ++n) {
        const int c0 = u.pn * 256 + bj * 128 + n * 16 + wc * 32 + 4 * fq;
        const f32x4 gv = *(const f32x4*)(gate + c0);
#pragma unroll
        for (int ai = 0; ai < 2; ++ai)
#pragma unroll
          for (int m = 0; m < 4; ++m) {
            const int row = row0 + ai * 128 + m * 16;
            const f32x4 xv = *(const f32x4*)(xin + (size_t)row * DM + c0);
            const f32x4 v = xv * ALPHA_DN + gv * acc[ai][bj][m][n];
            u32x2 o; o[0] = pk2(v[0], v[1]); o[1] = pk2(v[2], v[3]);
            *(u32x2*)(res16 + (size_t)row * DM + c0) = o;
          }
      }
    return true;
  }
};

struct Chunk { int c, L, logL, nseq, bbase; const float* xin0; float* xout; };
DEV Chunk make_chunk(const Params& p, int c) {
  Chunk k; k.c = c;
  if (c < 2) { k.L = 8192; k.logL = 13; k.nseq = 2; k.bbase = 2 * c; k.xin0 = p.x_prompt + (size_t)c * TCH * DM; }
  else { k.L = 16384; k.logL = 14; k.nseq = 1; k.bbase = 4 + (c - 2); k.xin0 = p.x_sample + (size_t)(c - 2) * TCH * DM; }
  k.xout = p.out + (size_t)c * TCH * DM;
  return k;
}

DEV void transpose_tile(const float* src, int ldsrc, bf16_t* dst, int lddst, int k0, int n0, bool perm, LAS float* tile) {
  const int tid = ltid();
#pragma unroll
  for (int rep = 0; rep < 2; ++rep) {
    const int kk = (tid >> 4) + rep * 32, n4 = (tid & 15) * 4;
    const f32x4 v = *(const f32x4*)(src + (size_t)(k0 + kk) * ldsrc + n0 + n4);
    tile[kk * 65 + n4 + 0] = v[0]; tile[kk * 65 + n4 + 1] = v[1]; tile[kk * 65 + n4 + 2] = v[2]; tile[kk * 65 + n4 + 3] = v[3];
  }
  __syncthreads();
  const int nn = tid >> 3, k8 = (tid & 7) * 8;
  const int sp = perm ? ((nn >> 1) + 32 * (nn & 1)) : nn;
  u32x4 o;
  o[0] = pk2(tile[(k8 + 0) * 65 + sp], tile[(k8 + 1) * 65 + sp]);
  o[1] = pk2(tile[(k8 + 2) * 65 + sp], tile[(k8 + 3) * 65 + sp]);
  o[2] = pk2(tile[(k8 + 4) * 65 + sp], tile[(k8 + 5) * 65 + sp]);
  o[3] = pk2(tile[(k8 + 6) * 65 + sp], tile[(k8 + 7) * 65 + sp]);
  *(u32x4*)(dst + (size_t)(n0 + nn) * lddst + k0 + k8) = o;
  __syncthreads();
}

DEV void phase0(const Params& p, LAS unsigned char* lds) {
  const int tid = ltid(), bid = blockIdx.x, nb = gridDim.x;
  LAS float* tile = (LAS float*)lds;
  unsigned char* ws = p.ws;
  for (int l = 0; l < 2; ++l) {
    { const float* src = p.w_in + (size_t)l * DM * NIN; bf16_t* dst = (bf16_t*)(ws + OFF_WIN) + (size_t)l * NIN * DM;
      for (int it = bid; it < 16 * 112; it += nb) { const int kt = it & 15, ntl = it >> 4; const int n0 = ntl * 64;
        transpose_tile(src, NIN, dst, DM, kt * 64, n0, (n0 >= 3072 && n0 < 3584), tile); } }
    { const float* src = p.w_br_a + (size_t)l * 512 * DM; bf16_t* dst = (bf16_t*)(ws + OFF_WA) + (size_t)l * DM * DM;
      for (int it = bid; it < 8 * 16; it += nb) transpose_tile(src, DM, dst, DM, (it & 7) * 64, (it >> 3) * 64, false, tile); }
    { const float* src = p.w_br_b + (size_t)l * 256 * DM; bf16_t* dst = (bf16_t*)(ws + OFF_WA) + (size_t)l * DM * DM + 512;
      for (int it = bid; it < 4 * 16; it += nb) transpose_tile(src, DM, dst, DM, (it & 3) * 64, (it >> 2) * 64, false, tile); }
    { const float* src = p.w_br_c + (size_t)l * 256 * DM; bf16_t* dst = (bf16_t*)(ws + OFF_WA) + (size_t)l * DM * DM + 768;
      for (int it = bid; it < 4 * 16; it += nb) transpose_tile(src, DM, dst, DM, (it & 3) * 64, (it >> 2) * 64, false, tile); }
    { const float* src = p.w_out + (size_t)l * DM * DM; bf16_t* dst = (bf16_t*)(ws + OFF_WO) + (size_t)l * DM * DM;
      for (int it = bid; it < 16 * 16; it += nb) transpose_tile(src, DM, dst, DM, (it & 15) * 64, (it >> 4) * 64, false, tile); }
  }
  { float* bp = (float*)(ws + OFF_BIAS);
    for (int i = bid * NTHR + tid; i < 2 * NIN; i += nb * NTHR) { const int l = i / NIN, n = i % NIN; int sn = n;
      if (n >= 3072 && n < 3584) { const int pp = n & 63; sn = (n & ~63) + (pp >> 1) + 32 * (pp & 1); }
      bp[i] = p.b_in[(size_t)l * NIN + sn]; } }
  { float* ada = (float*)(ws + OFF_ADA);
    LAS float* sc = (LAS float*)lds;
    LAS float* red = sc + 6 * 1024;
    bool loaded = false;
    for (int it = bid; it < 2 * 48; it += nb) {
      if (!loaded) { for (int i = tid; i < 6 * 1024; i += NTHR) { const int b = i >> 10, k = i & 1023; const float cv = (b < 4) ? p.c_prompt[b * 1024 + k] : p.c_sample[(b - 4) * 1024 + k]; sc[i] = siluf_(cv); } loaded = true; }
      __syncthreads();
      const int l = it / 48, n0 = (it % 48) * 64, nl = tid & 63, ks = tid >> 6;
      float a[6] = {0.f, 0.f, 0.f, 0.f, 0.f, 0.f};
      const float* w = p.w_ada + (size_t)l * DM * 3072 + (size_t)(ks * 128) * 3072 + n0 + nl;
      for (int kk = 0; kk < 128; ++kk) { const float wv = w[(size_t)kk * 3072];
#pragma unroll
        for (int b = 0; b < 6; ++b) a[b] = fmaf(sc[b * 1024 + ks * 128 + kk], wv, a[b]); }
#pragma unroll
      for (int b = 0; b < 6; ++b) red[(ks * 6 + b) * 64 + nl] = a[b];
      __syncthreads();
      if (tid < 384) { const int b = tid >> 6; float s = 0.f;
#pragma unroll
        for (int k2 = 0; k2 < 8; ++k2) s += red[(k2 * 6 + b) * 64 + nl];
        ada[((size_t)l * 6 + b) * 3072 + n0 + nl] = s + p.b_ada[(size_t)l * 3072 + n0 + nl]; }
      __syncthreads();
    } }
  { v2f* rt = (v2f*)(ws + OFF_ROPE);
    for (int i = bid * NTHR + tid; i < 16384 * 32; i += nb * NTHR) { const int pos = i >> 5, k = i & 31;
      const float invf = __builtin_amdgcn_exp2f(-(float)k * 0.41524101186092029f);
      const unsigned rfix = (unsigned)(invf * 683565275.5764316f);
      const unsigned prod = (unsigned)pos * rfix;
      const float fr_ = (float)(prod >> 8) * (1.0f / 16777216.0f);
      v2f o; float s_, c_; sincospif(2.0f * fr_, &s_, &c_); o.x = c_; o.y = s_; rt[i] = o; } }
  { float* H2 = (float*)(ws + OFF_H2);
    LAS float* zs = (LAS float*)lds;
    LAS float* h1s = zs + 1088;
    for (int it = bid; it < 2 * 768; it += nb) {
      const int l = it / 768, g32 = it % 768; const int jrow = g32 * 32;
      const int L = (jrow < 8192) ? 8192 : 16384; const int j0 = (jrow < 8192) ? jrow : jrow - 8192;
      __syncthreads();
      for (int i = tid; i < 32 * 33; i += NTHR) { const int jj = i / 33, e = i - jj * 33; const int j = j0 + jj; float z;
        if (e == 0) z = (float)j / (float)L;
        else { const int b = (e <= 16) ? e : e - 16; const float fr_ = (float)((j * b) & (L - 1)) / (float)L;
          z = (e <= 16) ? cospif(2.0f * fr_) : sinpif(2.0f * fr_); }
        zs[i] = z; }
      __syncthreads();
      const int jq = tid >> 6, k = tid & 63;
      { const float* w1 = p.hy_w1 + (size_t)l * 33 * 64;
        float a[4];
#pragma unroll
        for (int r = 0; r < 4; ++r) a[r] = p.hy_b1[l * 64 + k];
        for (int e = 0; e < 33; ++e) { const float w = w1[e * 64 + k];
#pragma unroll
          for (int r = 0; r < 4; ++r) a[r] = fmaf(zs[(jq + 8 * r) * 33 + e], w, a[r]); }
        const float fq_ = p.hy_freq[(l * 2 + 0) * 64 + k] * 0.3183098861837907f;
#pragma unroll
        for (int r = 0; r < 4; ++r) h1s[(jq + 8 * r) * 64 + k] = sinpif(fq_ * a[r]); }
      __syncthreads();
      { const float* w2 = p.hy_w2 + (size_t)l * 64 * 64;
        float a[4];
#pragma unroll
        for (int r = 0; r < 4; ++r) a[r] = p.hy_b2[l * 64 + k];
        for (int kk = 0; kk < 64; ++kk) { const float w = w2[kk * 64 + k];
#pragma unroll
          for (int r = 0; r < 4; ++r) a[r] = fmaf(h1s[(jq + 8 * r) * 64 + kk], w, a[r]); }
        const float fq_ = p.hy_freq[(l * 2 + 1) * 64 + k] * 0.3183098861837907f;
#pragma unroll
        for (int r = 0; r < 4; ++r) H2[((size_t)l * 24576 + jrow + jq + 8 * r) * 64 + k] = sinpif(fq_ * a[r]); }
    }
    __syncthreads(); }
  { bf16_t* w3h = (bf16_t*)(ws + OFF_W3T);
    for (int i = bid * NTHR + tid; i < 2 * 2048 * 64; i += nb * NTHR) { const int l = i >> 17, k = (i >> 11) & 63, col = i & 2047;
      w3h[((size_t)l * 2048 + col) * 64 + k] = f2bf(p.hy_w3[(size_t)l * 64 * 2048 + (size_t)k * 2048 + col]); } }
  { v2f* tw = (v2f*)(ws + OFF_TW);
    for (int i = bid * NTHR + tid; i < 32768; i += nb * NTHR) { float s_, c_; sincospif((float)i * (1.0f / 16384.0f), &s_, &c_); v2f o; o.x = c_; o.y = s_; tw[i] = o; } }
  if (bid == 0 && tid < 64) ((unsigned*)(ws + OFF_CTR))[tid] = 0u;
}

DEV bf16x8 ld_frag(const bf16_t* p) { return *(const bf16x8*)p; }
DEV bf16x8 cvt8_f32(const float* p) {
  const f32x4 v0 = *(const f32x4*)p, v1 = *(const f32x4*)(p + 4);
  u32x4 r; r[0] = pk2(v0[0], v0[1]); r[1] = pk2(v0[2], v0[3]); r[2] = pk2(v1[0], v1[1]); r[3] = pk2(v1[2], v1[3]);
  return __builtin_bit_cast(bf16x8, r);
}
DEV void phase_fa(const Params& p, LAS unsigned char* lds, int l, int L) {
  (void)lds;
  const int tid = ltid(), lane = tid & 63, c = lane & 15, kq = lane >> 4;
  const int wv = blockIdx.x * (NTHR / 64) + __builtin_amdgcn_readfirstlane(tid >> 6), nw = gridDim.x * (NTHR / 64);
  float* KT = (float*)(p.ws + OFF_KF);
  const float* H2 = (const float*)(p.ws + OFF_H2) + ((size_t)l * 24576 + (L == 8192 ? 0 : 8192)) * 64;
  const bf16_t* w3h = (const bf16_t*)(p.ws + OFF_W3T) + (size_t)l * 2048 * 64;
  const float invL = 1.0f / (float)L;
  const int nitems = (L / 16) * 4;
  for (int it = wv; it < nitems; it += nw) {
    const int jt = it >> 2, cc = it & 3;
    const int j0 = jt * 16;
    const float* hr = H2 + (size_t)(j0 + c) * 64 + 8 * kq;
    const bf16x8 a0 = cvt8_f32(hr), a1 = cvt8_f32(hr + 32);
    const int dir = cc >> 1, o = cc & 1;
    const int jr = j0 + 4 * kq;
    const float t0 = (float)jr * invL, t1 = (float)(jr + 1) * invL, t2 = (float)(jr + 2) * invL, t3 = (float)(jr + 3) * invL;
#pragma unroll 2
    for (int nt = 0; nt < 32; ++nt) {
      const int ch = nt * 16 + c, col = cc * 512 + ch;
      const bf16_t* wp = w3h + (size_t)col * 64 + 8 * kq;
      f32x4 acc = {0.f, 0.f, 0.f, 0.f};
      acc = MFMA16(a0, ld_frag(wp), acc);
      acc = MFMA16(a1, ld_frag(wp + 32), acc);
      const float bias = p.hy_b3[l * 2048 + col], dec = fabsf(p.hy_decay[l * 512 + ch]);
      f32x4 v;
      v[0] = (acc[0] + bias) * __expf(-t0 * dec); v[1] = (acc[1] + bias) * __expf(-t1 * dec);
      v[2] = (acc[2] + bias) * __expf(-t2 * dec); v[3] = (acc[3] + bias) * __expf(-t3 * dec);
      float* kt = KT + ((size_t)(o * 512 + ch)) * (size_t)(2 * L);
      if (dir == 0) *(f32x4*)(kt + jr) = v;
      else {
        if (jr == 0) kt[L] = 0.f; else kt[2 * L - jr] = v[0];
        kt[2 * L - jr - 1] = v[1]; kt[2 * L - jr - 2] = v[2]; kt[2 * L - jr - 3] = v[3];
      }
    }
  }
}
DEV void phase_fb(const Params& p, LAS unsigned char* lds, int l, int L, int logL) {
  const int tid = ltid();
  LDSF2* x = (LDSF2*)lds; LAS float* red = (LAS float*)(lds + LDS_MAIN);
  const v2f* TW = (const v2f*)(p.ws + OFF_TW);
  const int N = L;
  for (int it = blockIdx.x; it < 1024; it += gridDim.x) {
    v2f* kf = (v2f*)(p.ws + OFF_KF) + (size_t)it * N;
    __syncthreads();
    float s = 0.f;
    for (int m = tid; m < N; m += NTHR) { const v2f v = kf[m]; s += fabsf(v.x) + fabsf(v.y); x[PIDX(m)] = v; }
    const float S = block_sum(s, red);
    __syncthreads();
    fft_fwd(x, N, tid, NTHR, TW);
    const float invN = 1.0f / (float)N;
    spec_unpack(x, N, logL, kf, invN / (S + 1e-6f), p.hy_skip[l * 1024 + it] * invN, tid, NTHR, TW);
  }
  __syncthreads();
}

DEV void phase_lnmod(const Params& p, const Chunk& ck, int l) {
  const int tid_ = ltid(); const int lane = tid_ & 63, wv = (blockIdx.x * NTHR + tid_) >> 6, nw = gridDim.x * (NTHR / 64);
  const float* xin = (l == 0) ? ck.xin0 : ck.xout;
  bf16_t* H = (bf16_t*)(p.ws + OFF_H);
  const float* ada = (const float*)(p.ws + OFF_ADA) + (size_t)l * 6 * 3072;
#pragma unroll 2
  for (int r = wv; r < TCH; r += nw) {
    const float* xr = xin + (size_t)r * DM;
    f32x4 v[4]; float s = 0.f;
#pragma unroll
    for (int q = 0; q < 4; ++q) { v[q] = *(const f32x4*)(xr + q * 256 + lane * 4); s += v[q][0] + v[q][1] + v[q][2] + v[q][3]; }
    const float mu = wave_sum(s) * (1.0f / 1024.0f);
    float s2 = 0.f;
#pragma unroll
    for (int q = 0; q < 4; ++q) { v[q] -= mu; s2 += v[q][0] * v[q][0] + v[q][1] * v[q][1] + v[q][2] * v[q][2] + v[q][3] * v[q][3]; }
    const float rstd = rsqrtf(wave_sum(s2) * (1.0f / 1024.0f) + 1e-5f);
    const float* ar = ada + (size_t)(ck.bbase + r / ck.L) * 3072;
#pragma unroll
    for (int q = 0; q < 4; ++q) { const int c = q * 256 + lane * 4;
      const f32x4 sh = *(const f32x4*)(ar + c), scl = *(const f32x4*)(ar + 1024 + c);
      const f32x4 h = v[q] * rstd * (scl + 1.0f) + sh;
      u32x2 o; o[0] = pk2(h[0], h[1]); o[1] = pk2(h[2], h[3]);
      *(u32x2*)(H + (size_t)r * DM + c) = o; }
  }
}
DEV void phase_lnfinal(const Params& p, const Chunk& ck, int l) {
  const int tid_ = ltid(); const int lane = tid_ & 63, wv = (blockIdx.x * NTHR + tid_) >> 6, nw = gridDim.x * (NTHR / 64);
  const float* g = p.ln_g + l * DM; const float* b = p.ln_b + l * DM;
#pragma unroll 2
  for (int r = wv; r < TCH; r += nw) {
    float* xr = ck.xout + (size_t)r * DM;
    const bf16_t* rr = (const bf16_t*)(p.ws + OFF_RES) + (size_t)r * DM;
    f32x4 v[4]; float s = 0.f;
#pragma unroll
    for (int q = 0; q < 4; ++q) { const u32x2 w = *(const u32x2*)(rr + q * 256 + lane * 4);
      v[q][0] = bflo(w[0]); v[q][1] = bfhi(w[0]); v[q][2] = bflo(w[1]); v[q][3] = bfhi(w[1]); s += v[q][0] + v[q][1] + v[q][2] + v[q][3]; }
    const float mu = wave_sum(s) * (1.0f / 1024.0f);
    float s2 = 0.f;
#pragma unroll
    for (int q = 0; q < 4; ++q) { v[q] -= mu; s2 += v[q][0] * v[q][0] + v[q][1] * v[q][1] + v[q][2] * v[q][2] + v[q][3] * v[q][3]; }
    const float rstd = rsqrtf(wave_sum(s2) * (1.0f / 1024.0f) + 1e-5f);
#pragma unroll
    for (int q = 0; q < 4; ++q) { const int c = q * 256 + lane * 4;
      const f32x4 gv = *(const f32x4*)(g + c), bv = *(const f32x4*)(b + c);
      __builtin_nontemporal_store(v[q] * rstd * gv + bv, (f32x4*)(xr + c)); }
  }
}

DEV float shortconv(const bf16_t* u, int t, int L, float w0, float w1, float w2, float cb) {
  float a = fmaf(w1, bf2f(u[t]), cb);
  if (t > 0) a = fmaf(w0, bf2f(u[t - 1]), a);
  if (t + 1 < L) a = fmaf(w2, bf2f(u[t + 1]), a);
  return a;
}
DEV void hyena_item(const Params& p, LAS unsigned char* lds, const Chunk& ck, int l, int item) {
  const int tid = ltid();
  LDSF2* x = (LDSF2*)lds;
  const v2f* TW = (const v2f*)(p.ws + OFF_TW);
  const int L = ck.L, N = L, H = L >> 1;
  const int seq = item >> 9, ch = item & 511;
  const int tb = seq * L;
  const bf16_t* UT = (const bf16_t*)(p.ws + OFF_UT);
  const bf16_t* u0 = UT + (size_t)ch * TCH + tb; const bf16_t* u1 = UT + (size_t)(512 + ch) * TCH + tb; const bf16_t* u2 = UT + (size_t)(1024 + ch) * TCH + tb;
  const float* cw = p.hy_conv_w + (size_t)l * 3 * 1536; const float* cb = p.hy_conv_b + (size_t)l * 1536;
  const v2f* kf0 = (const v2f*)(p.ws + OFF_KF) + (size_t)ch * N; const v2f* kf1 = (const v2f*)(p.ws + OFF_KF) + (size_t)(512 + ch) * N;
  bf16_t* yT = (bf16_t*)(p.ws + OFF_YT) + (size_t)ch * TCH + tb;
  __syncthreads();
  { const float w0 = cw[ch], w1 = cw[1536 + ch], w2 = cw[3072 + ch], b = cb[ch];
    for (int m = tid; m < H; m += NTHR) { v2f v;
      v.x = shortconv(u0, 2 * m, L, w0, w1, w2, b); v.y = shortconv(u0, 2 * m + 1, L, w0, w1, w2, b);
      x[PIDX(m)] = v; } }
  __syncthreads();
  fft_fwd<true>(x, N, tid, NTHR, TW);
  spec_mul(x, N, ck.logL, kf0, tid, NTHR, TW);
  __syncthreads();
  fft_inv<true>(x, N, tid, NTHR, TW);
  { const float w0 = cw[512 + ch], w1 = cw[1536 + 512 + ch], w2 = cw[3072 + 512 + ch], b = cb[512 + ch];
    for (int m = tid; m < H; m += NTHR) { v2f v = x[PIDX(m)];
      v.x *= shortconv(u1, 2 * m, L, w0, w1, w2, b); v.y *= shortconv(u1, 2 * m + 1, L, w0, w1, w2, b);
      x[PIDX(m)] = v; } }
  __syncthreads();
  fft_fwd<true>(x, N, tid, NTHR, TW);
  spec_mul(x, N, ck.logL, kf1, tid, NTHR, TW);
  __syncthreads();
  fft_inv<true>(x, N, tid, NTHR, TW);
  { const float w0 = cw[1024 + ch], w1 = cw[1536 + 1024 + ch], w2 = cw[3072 + 1024 + ch], b = cb[1024 + ch];
    for (int m = tid; m < H; m += NTHR) { const v2f v = x[PIDX(m)];
      const float y0 = v.x * shortconv(u2, 2 * m, L, w0, w1, w2, b), y1 = v.y * shortconv(u2, 2 * m + 1, L, w0, w1, w2, b);
      *(unsigned*)(yT + 2 * m) = pk2(y0, y1); } }
}

DEV float qmax4(float v) { v = fmaxf(v, __shfl_xor(v, 16)); return fmaxf(v, __shfl_xor(v, 32)); }
DEV float qsum4(float v) { v += __shfl_xor(v, 16); return v + __shfl_xor(v, 32); }
DEV bf16x8 pack_p(const f32x4& a, const f32x4& b) {
  u32x4 r; r[0] = pk2(a[0], a[1]); r[1] = pk2(a[2], a[3]); r[2] = pk2(b[0], b[1]); r[3] = pk2(b[2], b[3]);
  return __builtin_bit_cast(bf16x8, r);
}
DEV bf16x8 gather_v(const bf16_t* vb, const int (&o0)[4], const int (&o1)[4], bool has1) {
  u32x4 r;
  r[0] = (unsigned)vb[o0[0]] | ((unsigned)vb[o0[1]] << 16); r[1] = (unsigned)vb[o0[2]] | ((unsigned)vb[o0[3]] << 16);
  if (has1) { r[2] = (unsigned)vb[o1[0]] | ((unsigned)vb[o1[1]] << 16); r[3] = (unsigned)vb[o1[2]] | ((unsigned)vb[o1[3]] << 16); }
  else { r[2] = 0u; r[3] = 0u; }
  return __builtin_bit_cast(bf16x8, r);
}

typedef short s16x4 __attribute__((ext_vector_type(4)));
constexpr int VT_STRIDE = 160, VT_TILE = 16 * VT_STRIDE;
DEV void stage_v(LAS unsigned char* wl, int tt, const bf16_t* vrow  , int c, int qd) {
  const u32x4 v0 = *(const u32x4*)vrow, v1 = *(const u32x4*)(vrow + 32);
  LAS unsigned char* d = wl + tt * VT_TILE + c * VT_STRIDE + 16 * qd;
  *(LAS u32x4*)d = v0; *(LAS u32x4*)(d + 64) = v1;
}
DEV bf16x8 read_vt(LAS unsigned char* wl, int nt, int c, int qd, bool has1) {
  LAS unsigned char* a = wl + (4 * qd + (c >> 2)) * VT_STRIDE + (16 * nt + 4 * (c & 3)) * 2;
  const s16x4 lo = __builtin_amdgcn_ds_read_tr16_b64_v4i16((LAS s16x4*)a);
  s16x4 hi = {0, 0, 0, 0};
  if (has1) hi = __builtin_amdgcn_ds_read_tr16_b64_v4i16((LAS s16x4*)(a + VT_TILE));
  bf16x8 r; r[0] = lo[0]; r[1] = lo[1]; r[2] = lo[2]; r[3] = lo[3]; r[4] = hi[0]; r[5] = hi[1]; r[6] = hi[2]; r[7] = hi[3];
  return r;
}

DEV void dil_wave(const Params& p, const Chunk& ck, int g, int tile, int h, LAS unsigned char* wl) {
  const int lane = ltid() & 63, c = lane & 15, qd = lane >> 4;
  const int logd = 2 * g, dl = 1 << logd;
  const int L = ck.L, Ld = L >> logd, tps = L >> 4;
  const int seq = tile / tps, tau = tile - seq * tps, j = tau & (dl - 1), a = tau >> logd;
  const int sb = seq * L;
  const bf16_t* P = (const bf16_t*)(p.ws + OFF_P);
  const int iq = 16 * a + c, tq = sb + iq * dl + j;
  const bf16_t* qp = P + (size_t)tq * PLD + COL_CQ + h * 64 + 8 * qd;
  const bf16x8 q0 = ld_frag(qp), q1 = ld_frag(qp + 32);
  f32x4 S[9]; int vtok[9];
  const int ib = 16 * a - 64;
#pragma unroll
  for (int kt = 0; kt < 9; ++kt) {
    const int ik = ib + 16 * kt + c; const int ikc = min(max(ik, 0), Ld - 1);
    const bf16_t* kp = P + (size_t)(sb + ikc * dl + j) * PLD + COL_CK + h * 64 + 8 * qd;
    f32x4 acc = {0.f, 0.f, 0.f, 0.f};
    acc = MFMA16(ld_frag(kp), q0, acc);
    acc = MFMA16(ld_frag(kp + 32), q1, acc);
#pragma unroll
    for (int jj = 0; jj < 4; ++jj) { const int i2 = ib + 16 * kt + 4 * qd + jj; const int df = i2 - iq;
      const bool ok = (i2 >= 0) && (i2 < Ld) && (df <= 64) && (df >= -64);
      acc[jj] = ok ? acc[jj] * 0.125f : -1e30f; }
    vtok[kt] = sb + ikc * dl + j;
    S[kt] = acc;
  }
  float mx = -1e30f;
#pragma unroll
  for (int kt = 0; kt < 9; ++kt) mx = fmaxf(mx, fmaxf(fmaxf(S[kt][0], S[kt][1]), fmaxf(S[kt][2], S[kt][3])));
  mx = qmax4(mx);
  float ls = 0.f;
#pragma unroll
  for (int kt = 0; kt < 9; ++kt) {
#pragma unroll
    for (int jj = 0; jj < 4; ++jj) { const float e = __expf(S[kt][jj] - mx); S[kt][jj] = e; ls += e; } }
  ls = qsum4(ls);
  f32x4 O[4];
#pragma unroll
  for (int nt = 0; nt < 4; ++nt) O[nt] = (f32x4){0.f, 0.f, 0.f, 0.f};
  const f32x4 zero4 = {0.f, 0.f, 0.f, 0.f};
#pragma unroll
  for (int pr = 0; pr < 5; ++pr) {
    const bool has1 = (pr < 4);
    const bf16x8 pf = pack_p(S[2 * pr], has1 ? S[has1 ? 2 * pr + 1 : 0] : zero4);
    stage_v(wl, 0, P + (size_t)vtok[2 * pr] * PLD + COL_CV + h * 64 + 8 * qd, c, qd);
    if (has1) stage_v(wl, 1, P + (size_t)vtok[has1 ? 2 * pr + 1 : 0] * PLD + COL_CV + h * 64 + 8 * qd, c, qd);
#pragma unroll
    for (int nt = 0; nt < 4; ++nt) {
      const bf16x8 vf = read_vt(wl, nt, c, qd, has1);
      O[nt] = MFMA16(vf, pf, O[nt]);
    }
  }
  const float inv = 1.0f / ls;
  bf16_t* dp = (bf16_t*)(p.ws + OFF_DP) + ((size_t)g * TCH + tq) * 256 + h * 64 + 4 * qd;
#pragma unroll
  for (int nt = 0; nt < 4; ++nt) { const f32x4 ov = O[nt] * inv; u32x2 o; o[0] = pk2(ov[0], ov[1]); o[1] = pk2(ov[2], ov[3]); *(u32x2*)(dp + 16 * nt) = o; }
  if (qd == 0) ((float*)(p.ws + OFF_LSE))[((size_t)g * TCH + tq) * 4 + h] = mx + __logf(ls);
}

DEV void na_wave(const Params& p, const Chunk& ck, int l, int tile, int h, LAS unsigned char* wl) {
  const int lane = ltid() & 63, c = lane & 15, qd = lane >> 4;
  const int L = ck.L, rows = L >> 6;
  const int t0 = tile * 16, seq = t0 / L, pos0 = t0 & (L - 1), r = pos0 >> 6, c0 = pos0 & 63;
  const int rs = min(max(r - 4, 0), rows - 8), cb = min(max(c0 - 8, 0), 32);
  const int cq = c0 + c, csq = min(max(cq - 8, 0), 48);
  bf16_t* P = (bf16_t*)(p.ws + OFF_P);
  const float* rpb = p.na_rpb + (size_t)(l * 4 + h) * 15 * 31;
  const int tq = t0 + c;
  const bf16_t* qp = P + (size_t)tq * PLD + COL_BQ + h * 64 + 8 * qd;
  const bf16x8 q0 = ld_frag(qp), q1 = ld_frag(qp + 32);
  const int kbase = seq * L + rs * 64 + cb;
  f32x4 S[16];
#pragma unroll
  for (int kt = 0; kt < 16; ++kt) {
    const int i = kt >> 1, hf = kt & 1;
    const bf16_t* kp = P + (size_t)(kbase + i * 64 + hf * 16 + c) * PLD + COL_BK + h * 64 + 8 * qd;
    f32x4 acc = {0.f, 0.f, 0.f, 0.f};
    acc = MFMA16(ld_frag(kp), q0, acc);
    acc = MFMA16(ld_frag(kp + 32), q1, acc);
    const float* rp = rpb + (rs + i - r + 7) * 31;
#pragma unroll
    for (int jj = 0; jj < 4; ++jj) { const int colk = cb + hf * 16 + 4 * qd + jj;
      const bool ok = (colk >= csq) && (colk < csq + 16);
      const int dc = min(max(colk - cq, -15), 15) + 15;
      acc[jj] = ok ? acc[jj] * 0.125f + rp[dc] : -1e30f; }
    S[kt] = acc;
  }
  float mx = -1e30f;
#pragma unroll
  for (int kt = 0; kt < 16; ++kt) mx = fmaxf(mx, fmaxf(fmaxf(S[kt][0], S[kt][1]), fmaxf(S[kt][2], S[kt][3])));
  mx = qmax4(mx);
  float ls = 0.f;
#pragma unroll
  for (int kt = 0; kt < 16; ++kt) {
#pragma unroll
    for (int jj = 0; jj < 4; ++jj) { const float e = __expf(S[kt][jj] - mx); S[kt][jj] = e; ls += e; } }
  ls = qsum4(ls);
  f32x4 O[4];
#pragma unroll
  for (int nt = 0; nt < 4; ++nt) O[nt] = (f32x4){0.f, 0.f, 0.f, 0.f};
#pragma unroll
  for (int i = 0; i < 8; ++i) {
    const bf16x8 pf = pack_p(S[2 * i], S[2 * i + 1]);
    const bf16_t* vr = P + (size_t)(kbase + i * 64 + c) * PLD + COL_BV + h * 64 + 8 * qd;
    stage_v(wl, 0, vr, c, qd); stage_v(wl, 1, vr + (size_t)16 * PLD, c, qd);
#pragma unroll
    for (int nt = 0; nt < 4; ++nt) {
      const bf16x8 vf = read_vt(wl, nt, c, qd, true);
      O[nt] = MFMA16(vf, pf, O[nt]);
    }
  }
  const float inv = 1.0f / ls;
  bf16_t* zp = P + (size_t)tq * PLD + COL_BZ + h * 64 + 4 * qd;
#pragma unroll
  for (int nt = 0; nt < 4; ++nt) { const u32x2 z = *(const u32x2*)(zp + 16 * nt); u32x2 o;
    o[0] = pk2(O[nt][0] * inv * bflo(z[0]), O[nt][1] * inv * bfhi(z[0]));
    o[1] = pk2(O[nt][2] * inv * bflo(z[1]), O[nt][3] * inv * bfhi(z[1]));
    *(u32x2*)(zp + 16 * nt) = o; }
}

DEV void dil_item(const Params& p, LAS unsigned char* lds, const Chunk& ck, int item) {
  const int wave = __builtin_amdgcn_readfirstlane(ltid() >> 6);
  const int g = item >> 9, wi = (item & 511) * 8 + wave;
  dil_wave(p, ck, g, wi >> 2, wi & 3, lds + wave * (2 * VT_TILE));
}
DEV void na_item(const Params& p, LAS unsigned char* lds, const Chunk& ck, int l, int item) {
  const int wave = __builtin_amdgcn_readfirstlane(ltid() >> 6);
  const int wi = item * 8 + wave;
  na_wave(p, ck, l, wi >> 2, wi & 3, lds + wave * (2 * VT_TILE));
}

DEV void phase_mixers(const Params& p, LAS unsigned char* lds, const Chunk& ck, int l) {
  unsigned* ctr = (unsigned*)(p.ws + OFF_CTR) + (l * 4 + ck.c);
  LAS int* slot = (LAS int*)(lds + LDS_MAIN + 512);
  const int nd = 3 * 512, nn = 512, nh = ck.nseq * 512;
  const int total = nd + nn + nh;
  for (;;) {
    __syncthreads();
    if (ltid() == 0) *slot = (int)atomicAdd(ctr, 1u);
    __syncthreads();
    const int it = *slot;
    if (it >= total) break;
    if (it < nh) { if (SEN(2)) hyena_item(p, lds, ck, l, it); }
    else if (it < nh + nd) { if (SEN(0)) dil_item(p, lds, ck, it - nh); }
    else { if (SEN(1)) na_item(p, lds, ck, l, it - nh - nd); }
  }
}

DEV void phase_ygate(const Params& p, LAS unsigned char* lds) {
  const int tid = ltid();
  {
    bf16_t* Pm = (bf16_t*)(p.ws + OFF_P);
    const bf16_t* DP = (const bf16_t*)(p.ws + OFF_DP); const float* LSE = (const float*)(p.ws + OFF_LSE);
#pragma unroll 2
    for (int i = blockIdx.x * NTHR + tid; i < TCH * 32; i += gridDim.x * NTHR) {
      const int tok = i >> 5, d8 = (i & 31) * 8, h = d8 >> 6;
      const float l0 = LSE[(size_t)tok * 4 + h], l1 = LSE[((size_t)TCH + tok) * 4 + h], l2 = LSE[((size_t)2 * TCH + tok) * 4 + h];
      const float lm = fmaxf(l0, fmaxf(l1, l2));
      float w0 = __expf(l0 - lm), w1 = __expf(l1 - lm), w2 = __expf(l2 - lm);
      const float wi = 1.0f / (w0 + w1 + w2); w0 *= wi; w1 *= wi; w2 *= wi;
      const bf16_t* a0 = DP + (size_t)tok * 256 + d8; const bf16_t* a1 = a0 + (size_t)TCH * 256; const bf16_t* a2 = a1 + (size_t)TCH * 256;
      const u32x4 q0 = __builtin_nontemporal_load((const u32x4*)a0), q1 = __builtin_nontemporal_load((const u32x4*)a1), q2 = __builtin_nontemporal_load((const u32x4*)a2);
      f32x4 x0, x1;
      x0[0] = bflo(q0[0]) * w0 + bflo(q1[0]) * w1 + bflo(q2[0]) * w2; x0[1] = bfhi(q0[0]) * w0 + bfhi(q1[0]) * w1 + bfhi(q2[0]) * w2;
      x0[2] = bflo(q0[1]) * w0 + bflo(q1[1]) * w1 + bflo(q2[1]) * w2; x0[3] = bfhi(q0[1]) * w0 + bfhi(q1[1]) * w1 + bfhi(q2[1]) * w2;
      x1[0] = bflo(q0[2]) * w0 + bflo(q1[2]) * w1 + bflo(q2[2]) * w2; x1[1] = bfhi(q0[2]) * w0 + bfhi(q1[2]) * w1 + bfhi(q2[2]) * w2;
      x1[2] = bflo(q0[3]) * w0 + bflo(q1[3]) * w1 + bflo(q2[3]) * w2; x1[3] = bfhi(q0[3]) * w0 + bfhi(q1[3]) * w1 + bfhi(q2[3]) * w2;
      bf16_t* zp = Pm + (size_t)tok * PLD + COL_CZ + d8;
      const u32x4 z = *(const u32x4*)zp; u32x4 o;
      o[0] = pk2(x0[0] * bflo(z[0]), x0[1] * bfhi(z[0])); o[1] = pk2(x0[2] * bflo(z[1]), x0[3] * bfhi(z[1]));
      o[2] = pk2(x1[0] * bflo(z[2]), x1[1] * bfhi(z[2])); o[3] = pk2(x1[2] * bflo(z[3]), x1[3] * bfhi(z[3]));
      *(u32x4*)zp = o;
    }
  }
  LAS bf16_t* tile = (LAS bf16_t*)lds;
  const bf16_t* yT = (const bf16_t*)(p.ws + OFF_YT);
  bf16_t* P = (bf16_t*)(p.ws + OFF_P);
  for (int it = blockIdx.x; it < 8 * (TCH / 64); it += gridDim.x) {
    const int ch0 = (it & 7) * 64, t0 = (it >> 3) * 64;
    __syncthreads();
    { const int i = tid >> 3, j8 = (tid & 7) * 8;
      const u32x4 v = __builtin_nontemporal_load((const u32x4*)(yT + (size_t)(ch0 + i) * TCH + t0 + j8));
      *(LAS u32x4*)(tile + i * 72 + j8) = v; }
    __syncthreads();
    { const int t = tid >> 3, c8 = (tid & 7) * 8;
      bf16_t* zp = P + (size_t)(t0 + t) * PLD + COL_AZ + ch0 + c8;
      const u32x4 z = *(const u32x4*)zp; u32x4 r;
      float y[8];
#pragma unroll
      for (int q = 0; q < 8; ++q) y[q] = bf2f(tile[(c8 + q) * 72 + t]);
      r[0] = pk2(y[0] * bflo(z[0]), y[1] * bfhi(z[0])); r[1] = pk2(y[2] * bflo(z[1]), y[3] * bfhi(z[1]));
      r[2] = pk2(y[4] * bflo(z[2]), y[5] * bfhi(z[2])); r[3] = pk2(y[6] * bflo(z[3]), y[7] * bfhi(z[3]));
      *(u32x4*)zp = r; }
  }
}

#ifndef ONLY
#define ONLY -1
#endif
#define EN(k) (ONLY < 0 || ONLY == (k))
#define XB_TMO      128
#define XB_XCNT(j)  (256  + 64 * (j))
#define XB_XSUB(j)  (1280 + 64 * (j))
#define XB_XGEN(j)  (2304 + 64 * (j))
#define XB_TOP      3328
#define XB_TOPGEN   3392
#define XCD_BAR_WORDS 3456
#define XB_SPIN_CAP (1u << 18)
DEV unsigned xb_ld(unsigned* p)              { return __hip_atomic_load(p, __ATOMIC_RELAXED, __HIP_MEMORY_SCOPE_AGENT); }
DEV unsigned xb_add(unsigned* p, unsigned v) { return __hip_atomic_fetch_add(p, v, __ATOMIC_RELAXED, __HIP_MEMORY_SCOPE_AGENT); }
DEV unsigned xb_xcc_id() { return (unsigned)__builtin_amdgcn_s_getreg((3 << 11) | 20) & 0xFu; }
#define XB_SPIN(cond, bar) do { unsigned _sp = 0; while (cond) { __builtin_amdgcn_s_sleep(1); \
    if ((++_sp & 255u) == 0u) { if (xb_ld(&(bar)[XB_TMO])) break; if (_sp > XB_SPIN_CAP) { atomicAdd(&(bar)[XB_TMO], 1u); break; } } } } while (0)
struct XcdBarrier { unsigned* bar; unsigned x; volatile LAS unsigned* st; };
DEV XcdBarrier xcd_barrier_post(unsigned* bar, volatile LAS unsigned* st) {
  XcdBarrier b; b.bar = bar; b.x = xb_xcc_id(); b.st = st;
  if (threadIdx.x == 0) (void)xb_add(&bar[XB_XCNT(b.x)], 1u);
  return b;
}
DEV void xcd_barrier_complete(unsigned* bar, unsigned x, unsigned& nloc, unsigned& nx) {
  const unsigned G = gridDim.x * gridDim.y * gridDim.z;
  unsigned sum, cnt, mine, sp = 0u;
  for (;;) {
    sum = 0u; cnt = 0u; mine = 0u;
#pragma unroll
    for (unsigned j = 0; j < 16; ++j) { const unsigned c = xb_ld(&bar[XB_XCNT(j)]); sum += c; cnt += (c > 0u) ? 1u : 0u; mine = (j == x) ? c : mine; }
    if (sum == G) break;
    __builtin_amdgcn_s_sleep(1);
    if ((++sp & 255u) == 0u) { if (xb_ld(&bar[XB_TMO])) break; if (sp > XB_SPIN_CAP) { atomicAdd(&bar[XB_TMO], 1u); break; } }
  }
  nloc = mine > 0u ? mine : 1u; nx = cnt > 0u ? cnt : 1u;
}
DEV void xcd_barrier(const XcdBarrier& b) {
  asm volatile("s_waitcnt vmcnt(0)" ::: "memory");
  __syncthreads();
  if (threadIdx.x == 0) {
    unsigned* bar = b.bar;
    __builtin_amdgcn_s_waitcnt(0);
    unsigned nloc = b.st[0], nx = b.st[1];
    if (nloc == 0u) { xcd_barrier_complete(bar, b.x, nloc, nx); b.st[0] = nloc; b.st[1] = nx; }
    const unsigned old = xb_add(&bar[XB_XSUB(b.x)], 1u);
    const unsigned gen = old / nloc;
    if (old + 1u == (gen + 1u) * nloc) {
      __builtin_amdgcn_fence(__ATOMIC_RELEASE, "agent");
      asm volatile("s_waitcnt vmcnt(0)" ::: "memory");
      const unsigned og = xb_add(&bar[XB_TOP], 1u);
      const unsigned tg = og / nx;
      if (og + 1u == (tg + 1u) * nx) xb_add(&bar[XB_TOPGEN], 1u);
      else XB_SPIN(xb_ld(&bar[XB_TOPGEN]) == tg, bar);
      __builtin_amdgcn_fence(__ATOMIC_ACQUIRE, "agent");
      xb_add(&bar[XB_XGEN(b.x)], 1u);
      asm volatile("s_waitcnt vmcnt(0)" ::: "memory");
    } else {
      XB_SPIN(xb_ld(&bar[XB_XGEN(b.x)]) == gen, bar);
      __builtin_amdgcn_fence(__ATOMIC_ACQUIRE, "agent");
      asm volatile("s_waitcnt vmcnt(0)" ::: "memory");
    }
  }
  __syncthreads();
}

constexpr int NPHASES = 50;
DEV void run_phase(const Params& p, LAS unsigned char* lds, int ph) {
  if (ph == 0) { if (EN(0)) phase0(p, lds); return; }
  const int idx = ph - 1;
  if (idx == 48) { const Chunk ck = make_chunk(p, 3); if (EN(9)) phase_lnfinal(p, ck, 1); return; }
  const int l = idx / 24, c = (idx % 24) / 6, s = idx % 6;
  const Chunk ck = make_chunk(p, c);
  bf16_t* H = (bf16_t*)(p.ws + OFF_H); bf16_t* P = (bf16_t*)(p.ws + OFF_P);
  switch (s) {
    case 0: {
      if (!(l == 0 && c == 0)) { const int pl = (c == 0) ? l - 1 : l, pc = (c == 0) ? 3 : c - 1; const Chunk pk = make_chunk(p, pc); if (EN(9)) phase_lnfinal(p, pk, pl); }
      if (EN(3)) phase_lnmod(p, ck, l);
      if (c == 0) { if (EN(1)) phase_fa(p, lds, l, 8192); } else if (c == 2) { if (EN(1)) phase_fa(p, lds, l, 16384); }
    } break;
    case 1: if (EN(4)) { pg8::Gemm g{H, (const bf16_t*)(p.ws + OFF_WIN) + (size_t)l * NIN * DM, DM, DM, TCH, NIN, DM};
      EpiIn E{(const float*)(p.ws + OFF_BIAS) + l * NIN, (bf16_t*)(p.ws + OFF_UT), P, (const f32x4*)(p.ws + OFF_ROPE), ck.L};
      pg8::PlainSched S; S.init(g, gridDim.x, blockIdx.x); pg8::gemm_phase(lds, DM, DM, S, E); }
      if (c == 0) { if (EN(2)) phase_fb(p, lds, l, 8192, 13); } else if (c == 2) { if (EN(2)) phase_fb(p, lds, l, 16384, 14); }
      break;
    case 2: if (EN(5)) phase_mixers(p, lds, ck, l); break;
    case 3: if (EN(6)) phase_ygate(p, lds); break;
    case 4: if (EN(7)) { pg8::BranchSched S; S.init(P, (const bf16_t*)(p.ws + OFF_WA) + (size_t)l * DM * DM, gridDim.x, blockIdx.x);
      EpiBranch E{P, H}; pg8::gemm_phase(lds, PLD, DM, S, E); } break;
    default: if (EN(8)) { pg8::Gemm g{H, (const bf16_t*)(p.ws + OFF_WO) + (size_t)l * DM * DM, DM, DM, TCH, DM, DM};
      EpiOut E{(l == 0) ? ck.xin0 : ck.xout, (bf16_t*)(p.ws + OFF_RES), (const float*)(p.ws + OFF_ADA) + (size_t)l * 6 * 3072, ck.bbase, ck.L};
      pg8::PlainSched S; S.init(g, gridDim.x, blockIdx.x); pg8::gemm_phase(lds, DM, DM, S, E); } break;
  }
}

__global__ void __launch_bounds__(512, 2) fwd_megakernel(Params p) {
  extern __shared__ __attribute__((aligned(16))) unsigned char shm[];
  LAS unsigned char* lds = (LAS unsigned char*)shm;
  cg::grid_group grid = cg::this_grid();
  volatile LAS unsigned* stw = (volatile LAS unsigned*)(lds + LDS_MAIN + 768);
  if (threadIdx.x == 0) { stw[0] = 0u; stw[1] = 0u; }
  __syncthreads();
  const XcdBarrier xb = xcd_barrier_post((unsigned*)(p.ws + OFF_BAR), stw);
  for (int ph = p.ph_begin; ph < p.ph_end; ++ph) {
    Params q = p; asm volatile("" : "+s"(q.ws), "+s"(q.out));
    run_phase(q, lds, ph);
    if (ph + 1 < p.ph_end) { if (p.ph_begin < 0) grid.sync(); else xcd_barrier(xb); }
  }
}

extern "C" void kernel_launch(void* const* d_in, const int* in_sizes, int n_in, void* d_out, int out_size, void* d_ws, size_t ws_size, hipStream_t stream) {
  (void)in_sizes; (void)n_in; (void)out_size;
  static int grid_blocks = 0;
  if (!grid_blocks) {
    int dev = 0, cus = 0, per_cu = 0;
    hipGetDevice(&dev);
    hipDeviceGetAttribute(&cus, hipDeviceAttributeMultiprocessorCount, dev);
    hipFuncSetAttribute((const void*)fwd_megakernel, hipFuncAttributeMaxDynamicSharedMemorySize, LDS_TOTAL);
    hipOccupancyMaxActiveBlocksPerMultiprocessor(&per_cu, fwd_megakernel, NTHR, LDS_TOTAL);
    if (per_cu < 1) per_cu = 1;
    grid_blocks = cus * per_cu;
  }
  if (ws_size < WS_NEED) { fprintf(stderr, "workspace too small: %zu < %zu\n", ws_size, (size_t)WS_NEED); return; }
  Params p{};
  p.x_prompt = (const float*)d_in[0]; p.x_sample = (const float*)d_in[1]; p.c_prompt = (const float*)d_in[2]; p.c_sample = (const float*)d_in[3];
  p.w_ada = (const float*)d_in[4]; p.b_ada = (const float*)d_in[5]; p.w_in = (const float*)d_in[6]; p.b_in = (const float*)d_in[7];
  p.hy_conv_w = (const float*)d_in[8]; p.hy_conv_b = (const float*)d_in[9]; p.hy_w1 = (const float*)d_in[10]; p.hy_b1 = (const float*)d_in[11];
  p.hy_freq = (const float*)d_in[12]; p.hy_w2 = (const float*)d_in[13]; p.hy_b2 = (const float*)d_in[14]; p.hy_w3 = (const float*)d_in[15];
  p.hy_b3 = (const float*)d_in[16]; p.hy_decay = (const float*)d_in[17]; p.hy_skip = (const float*)d_in[18]; p.na_rpb = (const float*)d_in[19];
  p.w_br_a = (const float*)d_in[20]; p.w_br_b = (const float*)d_in[21]; p.w_br_c = (const float*)d_in[22]; p.w_out = (const float*)d_in[23];
  p.ln_g = (const float*)d_in[24]; p.ln_b = (const float*)d_in[25];
  p.out = (float*)d_out; p.ws = (unsigned char*)d_ws;
  (void)hipMemsetAsync((unsigned char*)d_ws + OFF_BAR, 0, 16384, stream);
#if MULTI_LAUNCH
  for (int ph = 0; ph < NPHASES; ++ph) { p.ph_begin = ph; p.ph_end = ph + 1;
    hipLaunchKernelGGL(fwd_megakernel, dim3(grid_blocks), dim3(NTHR), LDS_TOTAL, stream, p); }
#else
  p.ph_begin = 0; p.ph_end = NPHASES;
  void* args[] = {&p};
  hipError_t e = hipLaunchCooperativeKernel((const void*)fwd_megakernel, dim3(grid_blocks), dim3(NTHR), args, LDS_TOTAL, stream);
  if (e != hipSuccess) fprintf(stderr, "cooperative launch failed: %s (grid %d)\n", hipGetErrorString(e), grid_blocks);
#endif
}
```

```cpp
#include <hip/hip_runtime.h>
#include <hip/hip_cooperative_groups.h>
#include <cstdio>
namespace cg = cooperative_groups;

#define DEV __device__ __forceinline__
#define LAS __attribute__((address_space(3)))
typedef unsigned short bf16_t;
typedef short bf16x8 __attribute__((ext_vector_type(8)));
typedef float f32x4 __attribute__((ext_vector_type(4)));
typedef float v2f __attribute__((ext_vector_type(2)));
typedef unsigned u32x4 __attribute__((ext_vector_type(4)));
typedef unsigned u32x2 __attribute__((ext_vector_type(2)));

constexpr int NTHR = 512;
constexpr int DM = 1024, NIN = 7168, TCH = 16384, PLD = 5632;
constexpr int COL_AZ = 0, COL_BQ = 512, COL_BK = 768, COL_BV = 1024, COL_BZ = 1280, COL_CQ = 1536, COL_CK = 1792, COL_CV = 2048,
              COL_CZ = 2304, COL_GA = 2560, COL_GB = 3584, COL_GC = 4608;
constexpr size_t MiB = 1024 * 1024;
constexpr size_t OFF_H = 0, OFF_P = 32 * MiB, OFF_UT = 208 * MiB, OFF_YT = 256 * MiB, OFF_MG = OFF_UT, OFF_RES = OFF_UT, OFF_KF = 272 * MiB,
                 OFF_WIN = 400 * MiB, OFF_WA = 428 * MiB, OFF_WB = 430 * MiB, OFF_WC = 431 * MiB, OFF_WO = 432 * MiB,
                 OFF_ROPE = 436 * MiB, OFF_H2 = 440 * MiB, OFF_BIAS = 452 * MiB, OFF_ADA = OFF_BIAS + 64 * 1024,
                 OFF_CTR = OFF_ADA + 256 * 1024, OFF_DP = 456 * MiB, OFF_LSE = 504 * MiB, OFF_BAR = 505 * MiB, OFF_TW = 505 * MiB + 65536, OFF_W3T = 506 * MiB, WS_NEED = 507 * MiB;
constexpr int LDS_MAIN = 135168;
constexpr int LDS_TOTAL = LDS_MAIN + 1024;
constexpr float ALPHA_DN = 1.41421356237309515f;

struct Params {
  const float* x_prompt; const float* x_sample; const float* c_prompt; const float* c_sample;
  const float* w_ada; const float* b_ada; const float* w_in; const float* b_in;
  const float* hy_conv_w; const float* hy_conv_b; const float* hy_w1; const float* hy_b1; const float* hy_freq;
  const float* hy_w2; const float* hy_b2; const float* hy_w3; const float* hy_b3; const float* hy_decay; const float* hy_skip;
  const float* na_rpb; const float* w_br_a; const float* w_br_b; const float* w_br_c; const float* w_out;
  const float* ln_g; const float* ln_b;
  float* out; unsigned char* ws;
  int ph_begin, ph_end;
};

DEV int ltid() { int t = threadIdx.x; asm volatile("" : "+v"(t)); return t; }
typedef _Float16 h16x2 __attribute__((ext_vector_type(2)));
typedef _Float16 h16x8 __attribute__((ext_vector_type(8)));
DEV float bf2f(bf16_t b) { return (float)__builtin_bit_cast(_Float16, b); }
DEV float bflo(unsigned w) { return (float)__builtin_bit_cast(h16x2, w)[0]; }
DEV float bfhi(unsigned w) { return (float)__builtin_bit_cast(h16x2, w)[1]; }
DEV bf16_t f2bf(float f) { return __builtin_bit_cast(bf16_t, (_Float16)f); }
DEV unsigned pk2(float lo, float hi) { h16x2 v; v[0] = (_Float16)lo; v[1] = (_Float16)hi; return __builtin_bit_cast(unsigned, v); }
#define MFMA16(a, b, c) __builtin_amdgcn_mfma_f32_16x16x32_f16(__builtin_bit_cast(h16x8, (a)), __builtin_bit_cast(h16x8, (b)), (c), 0, 0, 0)
DEV float sigmoidf_(float x) { return __builtin_amdgcn_rcpf(1.0f + __expf(-x)); }
DEV float siluf_(float x) { return x * __builtin_amdgcn_rcpf(1.0f + __expf(-x)); }

DEV float wave_sum(float v) {
#pragma unroll
  for (int m = 32; m >= 1; m >>= 1) v += __shfl_xor(v, m);
  return v;
}
DEV float block_sum(float v, LAS float* red) {
  v = wave_sum(v);
  __syncthreads();
  { const int t_ = ltid(); if ((t_ & 63) == 0) red[t_ >> 6] = v; }
  __syncthreads();
  float s = 0.f;
#pragma unroll
  for (int i = 0; i < NTHR / 64; ++i) s += red[i];
  return s;
}

#define LDSF2 LAS v2f
#define SYNC() __syncthreads()
#define SINCOS_TAB(idx, c, s) do { const float f_ = (float)(idx) * (1.0f / 32768.0f); c = __builtin_amdgcn_cosf(f_); s = __builtin_amdgcn_sinf(f_); } while (0)
#define BREV32(v) __brev(v)
#ifndef MULTI_LAUNCH
#define MULTI_LAUNCH 0
#endif
DEV int PIDX(int i) { return i + (i >> 5); }

DEV void w16(int m, float& c, float& s) {
  const float K = 0.70710678118654752f, C1 = 0.92387953251128674f, S1 = 0.38268343236508977f;
  switch (m & 7) {
    case 0: c = 1.f; s = 0.f; break;
    case 1: c = C1; s = -S1; break;
    case 2: c = K; s = -K; break;
    case 3: c = S1; s = -C1; break;
    case 4: c = 0.f; s = -1.f; break;
    case 5: c = -S1; s = -C1; break;
    case 6: c = -K; s = -K; break;
    default: c = -C1; s = -S1; break;
  }
}

template <int R>
DEV void dif_group(float (&xr)[R], float (&xi)[R], float wr, float wi) {
#pragma unroll
  for (int Ra = R; Ra >= 2; Ra >>= 1) {
    const int half = Ra >> 1;
#pragma unroll
    for (int q = 0; q < R; ++q) {
      const int p = q & (Ra - 1);
      if (p < half) {
        const int q2 = q + half;
        const float ar = xr[q], ai = xi[q], br = xr[q2], bi = xi[q2];
        xr[q] = ar + br; xi[q] = ai + bi;
        const float dr = ar - br, di = ai - bi;
        float c, s; w16(p * (16 / Ra), c, s);
        const float tr = wr * c - wi * s, ti = wr * s + wi * c;
        xr[q2] = dr * tr - di * ti; xi[q2] = dr * ti + di * tr;
      }
    }
    const float nr = wr * wr - wi * wi, ni = 2.f * wr * wi; wr = nr; wi = ni;
  }
}

template <int R>
DEV void dit_group_inv(float (&xr)[R], float (&xi)[R], float wr, float wi) {
  float war[4], wai[4];
  war[0] = wr; wai[0] = wi;
#pragma unroll
  for (int a = 1; a < 4; ++a) { war[a] = war[a - 1] * war[a - 1] - wai[a - 1] * wai[a - 1]; wai[a] = 2.f * war[a - 1] * wai[a - 1]; }
#pragma unroll
  for (int Ra = 2; Ra <= R; Ra <<= 1) {
    const int half = Ra >> 1;
    const int a = (Ra == R) ? 0 : ((Ra * 2 == R) ? 1 : ((Ra * 4 == R) ? 2 : 3));
#pragma unroll
    for (int q = 0; q < R; ++q) {
      const int p = q & (Ra - 1);
      if (p < half) {
        const int q2 = q + half;
        float c, s; w16(p * (16 / Ra), c, s);
        const float tr = war[a] * c - wai[a] * s, ti = war[a] * s + wai[a] * c;
        const float br = xr[q2] * tr + xi[q2] * ti, bi = xi[q2] * tr - xr[q2] * ti;
        const float ar = xr[q], ai = xi[q];
        xr[q] = ar + br; xi[q] = ai + bi;
        xr[q2] = ar - br; xi[q2] = ai - bi;
      }
    }
  }
}

template <int R, bool INV, bool ZHI = false, bool LOH = false>
DEV void fft_pass(LDSF2* x, int N, int S, int tid, int nthr, const v2f* TW) {
  const int Q = S / R;
  const int logQ = __builtin_ctz((unsigned)Q);
  const int ngroups = N / R;
#pragma unroll 2
  for (int g = tid; g < ngroups; g += nthr) {
    const int blk = g >> logQ, j = g & (Q - 1);
    const int base = blk * S + j;
    float xr[R], xi[R];
#pragma unroll
    for (int q = 0; q < R; ++q) { if (ZHI && q >= R / 2) { xr[q] = 0.f; xi[q] = 0.f; } else { const v2f v = x[PIDX(base + q * Q)]; xr[q] = v.x; xi[q] = v.y; } }
    float c, s; SINCOS_TAB(j * (32768 / S), c, s);
    if (INV) dit_group_inv<R>(xr, xi, c, -s); else dif_group<R>(xr, xi, c, -s);
#pragma unroll
    for (int q = 0; q < R; ++q) { if (LOH && q >= R / 2) continue; v2f v; v.x = xr[q]; v.y = xi[q]; x[PIDX(base + q * Q)] = v; }
  }
}

template <bool ZHI = false>
DEV void fft_fwd(LDSF2* x, int N, int tid, int nthr, const v2f* TW) {
  int S = N;
  if (ZHI) { fft_pass<16, false, true>(x, N, S, tid, nthr, TW); SYNC(); S >>= 4; }
  while (S >= 16) { fft_pass<16, false>(x, N, S, tid, nthr, TW); SYNC(); S >>= 4; }
  if (S == 8) { fft_pass<8, false>(x, N, 8, tid, nthr, TW); SYNC(); }
  else if (S == 4) { fft_pass<4, false>(x, N, 4, tid, nthr, TW); SYNC(); }
  else if (S == 2) { fft_pass<2, false>(x, N, 2, tid, nthr, TW); SYNC(); }
}
template <bool LOH = false>
DEV void fft_inv(LDSF2* x, int N, int tid, int nthr, const v2f* TW) {
  int rem = N; while (rem >= 16) rem >>= 4;
  int S = 1;
  if (rem == 8) { fft_pass<8, true>(x, N, 8, tid, nthr, TW); SYNC(); S = 8; }
  else if (rem == 4) { fft_pass<4, true>(x, N, 4, tid, nthr, TW); SYNC(); S = 4; }
  else if (rem == 2) { fft_pass<2, true>(x, N, 2, tid, nthr, TW); SYNC(); S = 2; }
  while (S < N) { S <<= 4; if (LOH && S == N) fft_pass<16, true, false, true>(x, N, S, tid, nthr, TW); else fft_pass<16, true>(x, N, S, tid, nthr, TW); SYNC(); }
}

DEV void spec_mul(LDSF2* x, int N, int logN, const v2f* Kf, int tid, int nthr, const v2f* TW) {
  const int twm = 16384 / N;
  for (int k = tid; k <= N / 2; k += nthr) {
    if (k == 0) {
      const v2f c = x[PIDX(0)]; const v2f kk = Kf[0];
      const float Y0 = (c.x + c.y) * kk.x, YN = (c.x - c.y) * kk.y;
      v2f d; d.x = 0.5f * (Y0 + YN); d.y = 0.5f * (Y0 - YN); x[PIDX(0)] = d;
    } else if (k == N / 2) {
      const v2f c = x[PIDX(1)]; const v2f kk = Kf[N / 2];
      const float yr = c.x * kk.x + c.y * kk.y, yi = c.x * kk.y - c.y * kk.x;
      v2f d; d.x = yr; d.y = -yi; x[PIDX(1)] = d;
    } else {
      const int p1 = PIDX((int)(BREV32((unsigned)k) >> (32 - logN)));
      const int p2 = PIDX((int)(BREV32((unsigned)(N - k)) >> (32 - logN)));
      const v2f c1 = x[p1], c2 = x[p2];
      const v2f k1 = Kf[k], k2 = Kf[N - k];
      const float er = 0.5f * (c1.x + c2.x), ei = 0.5f * (c1.y - c2.y);
      const float fr = 0.5f * (c1.x - c2.x), fi = 0.5f * (c1.y + c2.y);
      const float orr = fi, oi = -fr;
      float wc, ws; SINCOS_TAB(k * twm, wc, ws);
      const float wr = wc, wi = -ws;
      const float tr = wr * orr - wi * oi, ti = wr * oi + wi * orr;
      const float x1r = er + tr, x1i = ei + ti;
      const float x2r = er - tr, x2i = -(ei - ti);
      const float y1r = x1r * k1.x - x1i * k1.y, y1i = x1r * k1.y + x1i * k1.x;
      const float y2r = x2r * k2.x - x2i * k2.y, y2i = x2r * k2.y + x2i * k2.x;
      const float yer = 0.5f * (y1r + y2r), yei = 0.5f * (y1i - y2i);
      const float gr = 0.5f * (y1r - y2r), gi = 0.5f * (y1i + y2i);
      const float yor = gr * wr + gi * wi, yoi = gi * wr - gr * wi;
      v2f d1, d2;
      d1.x = yer - yoi; d1.y = yei + yor;
      d2.x = yer + yoi; d2.y = -yei + yor;
      x[p1] = d1; x[p2] = d2;
    }
  }
}

DEV void spec_unpack(const LDSF2* x, int N, int logN, v2f* Kf, float scale, float add, int tid, int nthr, const v2f* TW) {
  const int twm = 16384 / N;
  for (int k = tid; k <= N / 2; k += nthr) {
    if (k == 0) {
      const v2f c = x[PIDX(0)];
      v2f o; o.x = (c.x + c.y) * scale + add; o.y = (c.x - c.y) * scale + add; Kf[0] = o;
    } else if (k == N / 2) {
      const v2f c = x[PIDX(1)];
      v2f o; o.x = c.x * scale + add; o.y = -c.y * scale; Kf[N / 2] = o;
    } else {
      const int p1 = PIDX((int)(BREV32((unsigned)k) >> (32 - logN)));
      const int p2 = PIDX((int)(BREV32((unsigned)(N - k)) >> (32 - logN)));
      const v2f c1 = x[p1], c2 = x[p2];
      const float er = 0.5f * (c1.x + c2.x), ei = 0.5f * (c1.y - c2.y);
      const float fr = 0.5f * (c1.x - c2.x), fi = 0.5f * (c1.y + c2.y);
      const float orr = fi, oi = -fr;
      float wc, ws; SINCOS_TAB(k * twm, wc, ws);
      const float wr = wc, wi = -ws;
      const float tr = wr * orr - wi * oi, ti = wr * oi + wi * orr;
      v2f o1, o2;
      o1.x = (er + tr) * scale + add; o1.y = (ei + ti) * scale;
      o2.x = (er - tr) * scale + add; o2.y = -(ei - ti) * scale;
      Kf[k] = o1; Kf[N - k] = o2;
    }
  }
}
#ifndef SUB
#define SUB -1
#endif
#define SEN(k) (SUB < 0 || SUB == (k))

namespace pg8 {
constexpr int BM = 256, BK = 64, HALF = 128, HTB = HALF * BK * 2, STAGE_BYTES = 8 * HTB, NXCD = 8, WGM = 8;
DEV int lds_byte(int r, int c) { const int st = (r >> 4) * 2 + (c >> 5), rr = r & 15, cc = c & 31, ob = rr * 64 + cc * 2; return st * 1024 + (ob ^ (((ob >> 9) & 1) << 5)); }
DEV void stage_rc(int b, int& R, int& C) { const int st = b / 1024, sb = b % 1024, swz = sb ^ (((sb >> 9) & 1) << 5); R = (st >> 1) * 16 + swz / 64; C = (st & 1) * 32 + (swz % 64) / 2; }
struct Unit { int pm, pn, seg; };
struct Gemm { const bf16_t* A; const bf16_t* Bt; int lda, ldb, M, N, K; };
struct StaticOrder {
  int nM, nN, nwg, G, c;
  DEV void init(int M, int N, int G_, int c_) { nM = M / BM; nN = N / BM; nwg = nM * nN; G = G_; c = c_; }
  DEV bool next(int i, Unit& u) const {
    const long L = (long)i * G + c; if (L >= nwg) return false;
    int wgid = (int)L; { const int q = nwg / NXCD, r = nwg % NXCD, xcd = wgid % NXCD, off = wgid / NXCD; wgid = (xcd < r ? xcd * (q + 1) : r * (q + 1) + (xcd - r) * q) + off; }
    const int nig = WGM * nN, gid = wgid / nig, fm = gid * WGM, gsz = (nM - fm) < WGM ? (nM - fm) : WGM;
    u.pm = fm + ((wgid % nig) % gsz); u.pn = (wgid % nig) / gsz; return true;
  }
};
struct PlainSched {
  StaticOrder so; const char* A; const char* B; size_t tstepA, tstepB; int ntv;
  DEV void init(const Gemm& g, int G, int c) { so.init(g.M, g.N, G, c); A = (const char*)g.A; B = (const char*)g.Bt; tstepA = (size_t)BM * g.lda * 2; tstepB = (size_t)BM * g.ldb * 2; ntv = g.K / BK; }
  DEV bool next(int i, Unit& u) const { u.seg = 0; return so.next(i, u); }
  DEV const char* aptr(const Unit& u) const { return A + (size_t)u.pm * tstepA; }
  DEV const char* bptr(const Unit& u) const { return B + (size_t)u.pn * tstepB; }
  DEV int nt(const Unit&) const { return ntv; }
};
struct BranchSched {
  StaticOrder so; const char* A; const char* B; size_t tstepA, tstepB;
  DEV void init(const bf16_t* P, const bf16_t* W, int G, int c) { so.init(TCH, DM, G, c); A = (const char*)P; B = (const char*)W; tstepA = (size_t)BM * PLD * 2; tstepB = (size_t)BM * DM * 2; }
  DEV bool next(int i, Unit& u) const { const int ui = i / 3; if (!so.next(ui, u)) return false; u.seg = i - ui * 3; return true; }
  DEV const char* aptr(const Unit& u) const { const int col = (u.seg == 0) ? COL_AZ : ((u.seg == 1) ? COL_BZ : COL_CZ); return A + (size_t)u.pm * tstepA + col * 2; }
  DEV const char* bptr(const Unit& u) const { const int ko = (u.seg == 0) ? 0 : ((u.seg == 1) ? 512 : 768); return B + (size_t)u.pn * tstepB + ko * 2; }
  DEV int nt(const Unit& u) const { return (u.seg == 0) ? 8 : 4; }
};
template <class Epi, class Sched>
DEV void gemm_phase(LAS unsigned char* lds, const int lda, const int ldb, const Sched& S, const Epi& E) {
  const int tid = ltid(), wid = __builtin_amdgcn_readfirstlane(tid >> 6), lane = tid & 63, wr = wid >> 2, wc = wid & 3, fr = lane & 15, fq = lane >> 4;
  unsigned voffA[2], voffB[2];
#pragma unroll
  for (int i = 0; i < 2; ++i) { int R, C; stage_rc(tid * 16 + i * 8192, R, C);
    voffA[i] = (unsigned)(R * lda + C) * 2u; voffB[i] = (unsigned)(R * ldb + C) * 2u; }
  const size_t kstep = (size_t)(BK * 2);
  const size_t hstepA = (size_t)HALF * lda * 2, hstepB = (size_t)HALF * ldb * 2;
  const unsigned ldsw = (unsigned)wid * 1024u;
  const int aoff = lds_byte(wr * 64 + fr, fq * 8), boff = lds_byte(wc * 32 + fr, fq * 8);
#define PG8_SA(b, h) (((b) * 2 + (h)) * HTB)
#define PG8_SB(b, h) ((4 + (b) * 2 + (h)) * HTB)
#define PG8_STAGE(bufoff, gbase, voff) do { _Pragma("unroll") for (int _i = 0; _i < 2; ++_i) \
        __builtin_amdgcn_global_load_lds((const unsigned*)((const char*)(gbase) + (voff)[_i]), (LAS unsigned*)(lds + (bufoff) + ldsw + _i * 8192), 16, 0, 0); } while (0)
#define PG8_LDA(dst, b, h) do { _Pragma("unroll") for (int m = 0; m < 4; ++m) _Pragma("unroll") for (int k = 0; k < 2; ++k) dst[m][k] = *(const LAS bf16x8*)(lds + PG8_SA(b, h) + aoff + m * 2048 + k * 1024); } while (0)
#define PG8_LDB(dst, b, h) do { _Pragma("unroll") for (int n = 0; n < 2; ++n) _Pragma("unroll") for (int k = 0; k < 2; ++k) dst[n][k] = *(const LAS bf16x8*)(lds + PG8_SB(b, h) + boff + n * 2048 + k * 1024); } while (0)
#define PG8_MMA(ai, bj, At, Bt) do { __builtin_amdgcn_s_setprio(1); _Pragma("unroll") for (int m = 0; m < 4; ++m) _Pragma("unroll") for (int n = 0; n < 2; ++n) _Pragma("unroll") for (int k = 0; k < 2; ++k) \
        acc[ai][bj][m][n] = MFMA16(Bt[n][k], At[m][k], acc[ai][bj][m][n]); __builtin_amdgcn_s_setprio(0); } while (0)
#define PG8_WAIT_V(n) asm volatile("s_waitcnt vmcnt(" #n ")" ::: "memory")
#define PG8_WAIT_L(n) asm volatile("s_waitcnt lgkmcnt(" #n ")" ::: "memory")
#define PG8_BAR __builtin_amdgcn_s_barrier()
#define PG8_SCHED __builtin_amdgcn_sched_barrier(0)
  Unit cur, nxt; int ui = 0;
  if (!S.next(0, cur)) return;
  f32x4 acc[2][2][4][2];
#pragma unroll
  for (int a = 0; a < 2; ++a)
#pragma unroll
    for (int b = 0; b < 2; ++b)
#pragma unroll
      for (int m = 0; m < 4; ++m)
#pragma unroll
        for (int n = 0; n < 2; ++n) acc[a][b][m][n] = (f32x4){0.f, 0.f, 0.f, 0.f};
  bf16x8 At[4][2], B0[2][2], B1[2][2];
  const char* cA = S.aptr(cur); const char* cB = S.bptr(cur);
  int nt = S.nt(cur); asm volatile("" : "+s"(nt));
  PG8_STAGE(PG8_SB(0, 0), cB, voffB); PG8_STAGE(PG8_SA(0, 0), cA, voffA); PG8_STAGE(PG8_SB(0, 1), cB + hstepB, voffB); PG8_STAGE(PG8_SA(0, 1), cA + hstepA, voffA);
  if (wr == 1) PG8_BAR;
  PG8_WAIT_V(4); PG8_BAR;
  PG8_STAGE(PG8_SB(1, 0), cB + kstep, voffB); PG8_STAGE(PG8_SA(1, 0), cA + kstep, voffA); PG8_STAGE(PG8_SB(1, 1), cB + hstepB + kstep, voffB);
  PG8_WAIT_V(6); PG8_BAR;
  for (;;) {
    const bool has_next = S.next(ui + 1, nxt);
    const char* nA = has_next ? S.aptr(nxt) : cA; const char* nB = has_next ? S.bptr(nxt) : cB;
#pragma unroll 1
    for (int t = 0; t < nt; t += 2) {
      const bool last = (t == nt - 2);
      const char* a1 = cA + (size_t)(t + 1) * kstep;
      const char* a2 = last ? nA : cA + (size_t)(t + 2) * kstep; const char* b2 = last ? nB : cB + (size_t)(t + 2) * kstep;
      const char* a3 = a2 + kstep; const char* b3 = b2 + kstep;
      PG8_LDB(B0, 0, 0); PG8_SCHED; PG8_LDA(At, 0, 0); PG8_STAGE(PG8_SA(1, 1), a1 + hstepA, voffA);
      PG8_WAIT_L(8); PG8_BAR; PG8_WAIT_L(0); PG8_MMA(0, 0, At, B0); PG8_BAR; PG8_SCHED;
      PG8_LDB(B1, 0, 1); PG8_STAGE(PG8_SB(0, 0), b2, voffB);
      PG8_BAR; PG8_WAIT_L(0); PG8_MMA(0, 1, At, B1); PG8_BAR;
      PG8_LDA(At, 0, 1); PG8_STAGE(PG8_SA(0, 0), a2, voffA);
      PG8_BAR; PG8_WAIT_L(0); PG8_MMA(1, 0, At, B0); PG8_BAR; PG8_SCHED;
      PG8_STAGE(PG8_SB(0, 1), b2 + hstepB, voffB);
      PG8_WAIT_V(6); PG8_BAR; PG8_MMA(1, 1, At, B1); PG8_BAR;
      PG8_LDB(B0, 1, 0); PG8_SCHED; PG8_LDA(At, 1, 0); PG8_STAGE(PG8_SA(0, 1), a2 + hstepA, voffA);
      PG8_WAIT_L(8); PG8_BAR; PG8_WAIT_L(0); PG8_MMA(0, 0, At, B0); PG8_BAR; PG8_SCHED;
      PG8_LDB(B1, 1, 1); PG8_STAGE(PG8_SB(1, 0), b3, voffB);
      PG8_BAR; PG8_WAIT_L(0); PG8_MMA(0, 1, At, B1); PG8_BAR;
      PG8_LDA(At, 1, 1); PG8_STAGE(PG8_SA(1, 0), a3, voffA);
      PG8_BAR; PG8_WAIT_L(0); PG8_MMA(1, 0, At, B0); PG8_BAR; PG8_SCHED;
      PG8_STAGE(PG8_SB(1, 1), b3 + hstepB, voffB);
      PG8_WAIT_V(6); PG8_BAR; PG8_MMA(1, 1, At, B1); PG8_BAR;
    }
    const bool zero_after = E(acc, cur, wr, wc, fr, fq);
    if (!has_next) break;
    if (zero_after)
#pragma unroll
    for (int a = 0; a < 2; ++a)
#pragma unroll
      for (int b = 0; b < 2; ++b)
#pragma unroll
        for (int m = 0; m < 4; ++m)
#pragma unroll
          for (int n = 0; n < 2; ++n) acc[a][b][m][n] = (f32x4){0.f, 0.f, 0.f, 0.f};
    cur = nxt; cA = nA; cB = nB; ++ui; nt = S.nt(cur); asm volatile("" : "+s"(nt));
  }
  PG8_WAIT_V(0);
  if (wr == 0) PG8_BAR;
  PG8_BAR;
#undef PG8_SA
#undef PG8_SB
#undef PG8_STAGE
#undef PG8_LDA
#undef PG8_LDB
#undef PG8_MMA
#undef PG8_WAIT_V
#undef PG8_WAIT_L
#undef PG8_BAR
#undef PG8_SCHED
}
}

typedef f32x4 (&AccRef)[2][2][4][2];

struct EpiIn {
  const float* bias;
  bf16_t* UT; bf16_t* P; const f32x4* rope;
  int L;
  DEV bool operator()(AccRef acc, const pg8::Unit& u, int wr, int wc, int fr, int fq) const {
    const int pn = u.pn;
    const int row0 = u.pm * 256 + wr * 64 + fr;
    const int cl0 = wc * 32 + 4 * fq;
    if (pn < 6) {
#pragma unroll
      for (int bj = 0; bj < 2; ++bj)
#pragma unroll
        for (int n = 0; n < 2; ++n) {
          const int c0 = pn * 256 + bj * 128 + n * 16 + cl0;
          const f32x4 bv = *(const f32x4*)(bias + c0);
#pragma unroll
          for (int ai = 0; ai < 2; ++ai)
#pragma unroll
            for (int m = 0; m < 4; ++m) {
              const int row = row0 + ai * 128 + m * 16;
              const f32x4 v = acc[ai][bj][m][n] + bv;
              bf16_t* d = UT + (size_t)c0 * TCH + row;
              d[0] = f2bf(v[0]); d[TCH] = f2bf(v[1]); d[2 * TCH] = f2bf(v[2]); d[3 * TCH] = f2bf(v[3]);
            }
        }
      return true;
    }
    int mode = 0;
    if (pn == 6 || pn == 7 || pn == 11 || pn == 15) mode = 1; else if (pn >= 16) mode = 2; else if (pn == 12 || pn == 13) mode = 3;
#pragma unroll
    for (int bj = 0; bj < 2; ++bj)
#pragma unroll
      for (int n = 0; n < 2; ++n) {
        const int c0 = pn * 256 + bj * 128 + n * 16 + cl0;
        const int pc0 = c0 - 1536;
        const f32x4 bv = *(const f32x4*)(bias + c0);
#pragma unroll
        for (int ai = 0; ai < 2; ++ai)
#pragma unroll
          for (int m = 0; m < 4; ++m) {
            const int row = row0 + ai * 128 + m * 16;
            f32x4 v = acc[ai][bj][m][n] + bv;
            if (mode == 1) { v[0] = siluf_(v[0]); v[1] = siluf_(v[1]); v[2] = siluf_(v[2]); v[3] = siluf_(v[3]); }
            else if (mode == 2) { v[0] = sigmoidf_(v[0]); v[1] = sigmoidf_(v[1]); v[2] = sigmoidf_(v[2]); v[3] = sigmoidf_(v[3]); }
            else if (mode == 3) {
              const int pos = row & (L - 1);
              const f32x4 cs = rope[(size_t)pos * 16 + ((c0 & 63) >> 2)];
              const float a0 = v[0] * cs[0] - v[1] * cs[1], a1 = v[1] * cs[0] + v[0] * cs[1];
              const float a2 = v[2] * cs[2] - v[3] * cs[3], a3 = v[3] * cs[2] + v[2] * cs[3];
              v[0] = a0; v[1] = a1; v[2] = a2; v[3] = a3;
            }
            u32x2 o; o[0] = pk2(v[0], v[1]); o[1] = pk2(v[2], v[3]);
            *(u32x2*)(P + (size_t)row * PLD + pc0) = o;
          }
      }
    return true;
  }
};
struct EpiBranch {
  const bf16_t* P; bf16_t* Mout;
  DEV bool operator()(AccRef acc, const pg8::Unit& u, int wr, int wc, int fr, int fq) const {
    const int row0 = u.pm * 256 + wr * 64 + fr;
    const int seg = u.seg;
    const int numc = (seg == 0) ? COL_GA : ((seg == 1) ? COL_GB : COL_GC);
    const int denc = (seg == 0) ? COL_GB : COL_GC;
#pragma unroll
    for (int bj = 0; bj < 2; ++bj)
#pragma unroll
      for (int n = 0; n < 2; ++n) {
        const int c0 = u.pn * 256 + bj * 128 + n * 16 + wc * 32 + 4 * fq;
#pragma unroll
        for (int ai = 0; ai < 2; ++ai)
#pragma unroll
          for (int m = 0; m < 4; ++m) {
            const int row = row0 + ai * 128 + m * 16;
            const bf16_t* pr = P + (size_t)row * PLD + c0;
            const u32x2 gn = *(const u32x2*)(pr + numc);
            f32x4 v = acc[ai][bj][m][n];
            const float lo_ = (seg == 0) ? 0.0f : 1e-30f;
            const float n0 = fmaxf(bflo(gn[0]), lo_), n1 = fmaxf(bfhi(gn[0]), lo_), n2 = fmaxf(bflo(gn[1]), lo_), n3 = fmaxf(bfhi(gn[1]), lo_);
            if (seg < 2) {
              const u32x2 gd = *(const u32x2*)(pr + denc);
              v[0] *= n0 * __builtin_amdgcn_rcpf(fmaxf(bflo(gd[0]), 1e-30f)); v[1] *= n1 * __builtin_amdgcn_rcpf(fmaxf(bfhi(gd[0]), 1e-30f));
              v[2] *= n2 * __builtin_amdgcn_rcpf(fmaxf(bflo(gd[1]), 1e-30f)); v[3] *= n3 * __builtin_amdgcn_rcpf(fmaxf(bfhi(gd[1]), 1e-30f));
              acc[ai][bj][m][n] = v;
            } else {
              v[0] *= n0; v[1] *= n1; v[2] *= n2; v[3] *= n3;
              u32x2 o; o[0] = pk2(v[0], v[1]); o[1] = pk2(v[2], v[3]); *(u32x2*)(Mout + (size_t)row * DM + c0) = o;
            }
          }
      }
    return seg == 2;
  }
};
struct EpiOut {
  const float* xin; bf16_t* res16; const float* ada_l;
  int bbase, L;
  DEV bool operator()(AccRef acc, const pg8::Unit& u, int wr, int wc, int fr, int fq) const {
    const int row0 = u.pm * 256 + wr * 64 + fr;
    const int b = bbase + (u.pm * 256) / L;
    const float* gate = ada_l + b * 3072 + 2048;
#pragma unroll
    for (int bj = 0; bj < 2; ++bj)
#pragma unroll
      for (int n = 0; n < 2; ++n) {
        const int c0 = u.pn * 256 + bj * 128 + n * 16 + wc * 32 + 4 * fq;
        const f32x4 gv = *(const f32x4*)(gate + c0);
#pragma unroll
        for (int ai = 0; ai < 2; ++ai)
#pragma unroll
          for (int m = 0; m < 4; ++m) {
            const int row = row0 + ai * 128 + m * 16;
            const f32x4 xv = *(const f32x4*)(xin + (size_t)row * DM + c0);
            const f32x4 v = xv * ALPHA_DN + gv * acc[ai][bj][m][n];
            u32x2 o; o[0] = pk2(v[0], v[1]); o[1] = pk2(v[2], v[3]);
            *(u32x2*)(res16 + (size_t)row * DM + c0) = o;
          }
      }
    return true;
  }
};

struct Chunk { int c, L, logL, nseq, bbase; const float* xin0; float* xout; };
DEV Chunk make_chunk(const Params& p, int c) {
  Chunk k; k.c = c;
  if (c < 2) { k.L = 8192; k.logL = 13; k.nseq = 2; k.bbase = 2 * c; k.xin0 = p.x_prompt + (size_t)c * TCH * DM; }
  else { k.L = 16384; k.logL = 14; k.nseq = 1; k.bbase = 4 + (c - 2); k.xin0 = p.x_sample + (size_t)(c - 2) * TCH * DM; }
  k.xout = p.out + (size_t)c * TCH * DM;
  return k;
}

DEV void transpose_tile(const float* src, int ldsrc, bf16_t* dst, int lddst, int k0, int n0, bool perm, LAS float* tile) {
  const int tid = ltid();
#pragma unroll
  for (int rep = 0; rep < 2; ++rep) {
    const int kk = (tid >> 4) + rep * 32, n4 = (tid & 15) * 4;
    const f32x4 v = *(const f32x4*)(src + (size_t)(k0 + kk) * ldsrc + n0 + n4);
    tile[kk * 65 + n4 + 0] = v[0]; tile[kk * 65 + n4 + 1] = v[1]; tile[kk * 65 + n4 + 2] = v[2]; tile[kk * 65 + n4 + 3] = v[3];
  }
  __syncthreads();
  const int nn = tid >> 3, k8 = (tid & 7) * 8;
  const int sp = perm ? ((nn >> 1) + 32 * (nn & 1)) : nn;
  u32x4 o;
  o[0] = pk2(tile[(k8 + 0) * 65 + sp], tile[(k8 + 1) * 65 + sp]);
  o[1] = pk2(tile[(k8 + 2) * 65 + sp], tile[(k8 + 3) * 65 + sp]);
  o[2] = pk2(tile[(k8 + 4) * 65 + sp], tile[(k8 + 5) * 65 + sp]);
  o[3] = pk2(tile[(k8 + 6) * 65 + sp], tile[(k8 + 7) * 65 + sp]);
  *(u32x4*)(dst + (size_t)(n0 + nn) * lddst + k0 + k8) = o;
  __syncthreads();
}

DEV void phase0(const Params& p, LAS unsigned char* lds) {
  const int tid = ltid(), bid = blockIdx.x, nb = gridDim.x;
  LAS float* tile = (LAS float*)lds;
  unsigned char* ws = p.ws;
  for (int l = 0; l < 2; ++l) {
    { const float* src = p.w_in + (size_t)l * DM * NIN; bf16_t* dst = (bf16_t*)(ws + OFF_WIN) + (size_t)l * NIN * DM;
      for (int it = bid; it < 16 * 112; it += nb) { const int kt = it & 15, ntl = it >> 4; const int n0 = ntl * 64;
        transpose_tile(src, NIN, dst, DM, kt * 64, n0, (n0 >= 3072 && n0 < 3584), tile); } }
    { const float* src = p.w_br_a + (size_t)l * 512 * DM; bf16_t* dst = (bf16_t*)(ws + OFF_WA) + (size_t)l * DM * DM;
      for (int it = bid; it < 8 * 16; it += nb) transpose_tile(src, DM, dst, DM, (it & 7) * 64, (it >> 3) * 64, false, tile); }
    { const float* src = p.w_br_b + (size_t)l * 256 * DM; bf16_t* dst = (bf16_t*)(ws + OFF_WA) + (size_t)l * DM * DM + 512;
      for (int it = bid; it < 4 * 16; it += nb) transpose_tile(src, DM, dst, DM, (it & 3) * 64, (it >> 2) * 64, false, tile); }
    { const float* src = p.w_br_c + (size_t)l * 256 * DM; bf16_t* dst = (bf16_t*)(ws + OFF_WA) + (size_t)l * DM * DM + 768;
      for (int it = bid; it < 4 * 16; it += nb) transpose_tile(src, DM, dst, DM, (it & 3) * 64, (it >> 2) * 64, false, tile); }
    { const float* src = p.w_out + (size_t)l * DM * DM; bf16_t* dst = (bf16_t*)(ws + OFF_WO) + (size_t)l * DM * DM;
      for (int it = bid; it < 16 * 16; it += nb) transpose_tile(src, DM, dst, DM, (it & 15) * 64, (it >> 4) * 64, false, tile); }
  }
  { float* bp = (float*)(ws + OFF_BIAS);
    for (int i = bid * NTHR + tid; i < 2 * NIN; i += nb * NTHR) { const int l = i / NIN, n = i % NIN; int sn = n;
      if (n >= 3072 && n < 3584) { const int pp = n & 63; sn = (n & ~63) + (pp >> 1) + 32 * (pp & 1); }
      bp[i] = p.b_in[(size_t)l * NIN + sn]; } }
  { float* ada = (float*)(ws + OFF_ADA);
    LAS float* sc = (LAS float*)lds;
    LAS float* red = sc + 6 * 1024;
    bool loaded = false;
    for (int it = bid; it < 2 * 48; it += nb) {
      if (!loaded) { for (int i = tid; i < 6 * 1024; i += NTHR) { const int b = i >> 10, k = i & 1023; const float cv = (b < 4) ? p.c_prompt[b * 1024 + k] : p.c_sample[(b - 4) * 1024 + k]; sc[i] = siluf_(cv); } loaded = true; }
      __syncthreads();
      const int l = it / 48, n0 = (it % 48) * 64, nl = tid & 63, ks = tid >> 6;
      float a[6] = {0.f, 0.f, 0.f, 0.f, 0.f, 0.f};
      const float* w = p.w_ada + (size_t)l * DM * 3072 + (size_t)(ks * 128) * 3072 + n0 + nl;
      for (int kk = 0; kk < 128; ++kk) { const float wv = w[(size_t)kk * 3072];
#pragma unroll
        for (int b = 0; b < 6; ++b) a[b] = fmaf(sc[b * 1024 + ks * 128 + kk], wv, a[b]); }
#pragma unroll
      for (int b = 0; b < 6; ++b) red[(ks * 6 + b) * 64 + nl] = a[b];
      __syncthreads();
      if (tid < 384) { const int b = tid >> 6; float s = 0.f;
#pragma unroll
        for (int k2 = 0; k2 < 8; ++k2) s += red[(k2 * 6 + b) * 64 + nl];
        ada[((size_t)l * 6 + b) * 3072 + n0 + nl] = s + p.b_ada[(size_t)l * 3072 + n0 + nl]; }
      __syncthreads();
    } }
  { v2f* rt = (v2f*)(ws + OFF_ROPE);
    for (int i = bid * NTHR + tid; i < 16384 * 32; i += nb * NTHR) { const int pos = i >> 5, k = i & 31;
      const float invf = __builtin_amdgcn_exp2f(-(float)k * 0.41524101186092029f);
      const unsigned rfix = (unsigned)(invf * 683565275.5764316f);
      const unsigned prod = (unsigned)pos * rfix;
      const float fr_ = (float)(prod >> 8) * (1.0f / 16777216.0f);
      v2f o; float s_, c_; sincospif(2.0f * fr_, &s_, &c_); o.x = c_; o.y = s_; rt[i] = o; } }
  { float* H2 = (float*)(ws + OFF_H2);
    LAS float* zs = (LAS float*)lds;
    LAS float* h1s = zs + 1088;
    for (int it = bid; it < 2 * 768; it += nb) {
      const int l = it / 768, g32 = it % 768; const int jrow = g32 * 32;
      const int L = (jrow < 8192) ? 8192 : 16384; const int j0 = (jrow < 8192) ? jrow : jrow - 8192;
      __syncthreads();
      for (int i = tid; i < 32 * 33; i += NTHR) { const int jj = i / 33, e = i - jj * 33; const int j = j0 + jj; float z;
        if (e == 0) z = (float)j / (float)L;
        else { const int b = (e <= 16) ? e : e - 16; const float fr_ = (float)((j * b) & (L - 1)) / (float)L;
          z = (e <= 16) ? cospif(2.0f * fr_) : sinpif(2.0f * fr_); }
        zs[i] = z; }
      __syncthreads();
      const int jq = tid >> 6, k = tid & 63;
      { const float* w1 = p.hy_w1 + (size_t)l * 33 * 64;
        float a[4];
#pragma unroll
        for (int r = 0; r < 4; ++r) a[r] = p.hy_b1[l * 64 + k];
        for (int e = 0; e < 33; ++e) { const float w = w1[e * 64 + k];
#pragma unroll
          for (int r = 0; r < 4; ++r) a[r] = fmaf(zs[(jq + 8 * r) * 33 + e], w, a[r]); }
        const float fq_ = p.hy_freq[(l * 2 + 0) * 64 + k] * 0.3183098861837907f;
#pragma unroll
        for (int r = 0; r < 4; ++r) h1s[(jq + 8 * r) * 64 + k] = sinpif(fq_ * a[r]); }
      __syncthreads();
      { const float* w2 = p.hy_w2 + (size_t)l * 64 * 64;
        float a[4];
#pragma unroll
        for (int r = 0; r < 4; ++r) a[r] = p.hy_b2[l * 64 + k];
        for (int kk = 0; kk < 64; ++kk) { const float w = w2[kk * 64 + k];
#pragma unroll
          for (int r = 0; r < 4; ++r) a[r] = fmaf(h1s[(jq + 8 * r) * 64 + kk], w, a[r]); }
        const float fq_ = p.hy_freq[(l * 2 + 1) * 64 + k] * 0.3183098861837907f;
#pragma unroll
        for (int r = 0; r < 4; ++r) H2[((size_t)l * 24576 + jrow + jq + 8 * r) * 64 + k] = sinpif(fq_ * a[r]); }
    }
    __syncthreads(); }
  { bf16_t* w3h = (bf16_t*)(ws + OFF_W3T);
    for (int i = bid * NTHR + tid; i < 2 * 2048 * 64; i += nb * NTHR) { const int l = i >> 17, k = (i >> 11) & 63, col = i & 2047;
      w3h[((size_t)l * 2048 + col) * 64 + k] = f2bf(p.hy_w3[(size_t)l * 64 * 2048 + (size_t)k * 2048 + col]); } }
  { v2f* tw = (v2f*)(ws + OFF_TW);
    for (int i = bid * NTHR + tid; i < 32768; i += nb * NTHR) { float s_, c_; sincospif((float)i * (1.0f / 16384.0f), &s_, &c_); v2f o; o.x = c_; o.y = s_; tw[i] = o; } }
  if (bid == 0 && tid < 64) ((unsigned*)(ws + OFF_CTR))[tid] = 0u;
}

DEV bf16x8 ld_frag(const bf16_t* p) { return *(const bf16x8*)p; }
DEV bf16x8 cvt8_f32(const float* p) {
  const f32x4 v0 = *(const f32x4*)p, v1 = *(const f32x4*)(p + 4);
  u32x4 r; r[0] = pk2(v0[0], v0[1]); r[1] = pk2(v0[2], v0[3]); r[2] = pk2(v1[0], v1[1]); r[3] = pk2(v1[2], v1[3]);
  return __builtin_bit_cast(bf16x8, r);
}
DEV void phase_fa(const Params& p, LAS unsigned char* lds, int l, int L) {
  (void)lds;
  const int tid = ltid(), lane = tid & 63, c = lane & 15, kq = lane >> 4;
  const int wv = blockIdx.x * (NTHR / 64) + __builtin_amdgcn_readfirstlane(tid >> 6), nw = gridDim.x * (NTHR / 64);
  float* KT = (float*)(p.ws + OFF_KF);
  const float* H2 = (const float*)(p.ws + OFF_H2) + ((size_t)l * 24576 + (L == 8192 ? 0 : 8192)) * 64;
  const bf16_t* w3h = (const bf16_t*)(p.ws + OFF_W3T) + (size_t)l * 2048 * 64;
  const float invL = 1.0f / (float)L;
  const int nitems = (L / 16) * 4;
  for (int it = wv; it < nitems; it += nw) {
    const int jt = it >> 2, cc = it & 3;
    const int j0 = jt * 16;
    const float* hr = H2 + (size_t)(j0 + c) * 64 + 8 * kq;
    const bf16x8 a0 = cvt8_f32(hr), a1 = cvt8_f32(hr + 32);
    const int dir = cc >> 1, o = cc & 1;
    const int jr = j0 + 4 * kq;
    const float t0 = (float)jr * invL, t1 = (float)(jr + 1) * invL, t2 = (float)(jr + 2) * invL, t3 = (float)(jr + 3) * invL;
#pragma unroll 2
    for (int nt = 0; nt < 32; ++nt) {
      const int ch = nt * 16 + c, col = cc * 512 + ch;
      const bf16_t* wp = w3h + (size_t)col * 64 + 8 * kq;
      f32x4 acc = {0.f, 0.f, 0.f, 0.f};
      acc = MFMA16(a0, ld_frag(wp), acc);
      acc = MFMA16(a1, ld_frag(wp + 32), acc);
      const float bias = p.hy_b3[l * 2048 + col], dec = fabsf(p.hy_decay[l * 512 + ch]);
      f32x4 v;
      v[0] = (acc[0] + bias) * __expf(-t0 * dec); v[1] = (acc[1] + bias) * __expf(-t1 * dec);
      v[2] = (acc[2] + bias) * __expf(-t2 * dec); v[3] = (acc[3] + bias) * __expf(-t3 * dec);
      float* kt = KT + ((size_t)(o * 512 + ch)) * (size_t)(2 * L);
      if (dir == 0) *(f32x4*)(kt + jr) = v;
      else {
        if (jr == 0) kt[L] = 0.f; else kt[2 * L - jr] = v[0];
        kt[2 * L - jr - 1] = v[1]; kt[2 * L - jr - 2] = v[2]; kt[2 * L - jr - 3] = v[3];
      }
    }
  }
}
DEV void phase_fb(const Params& p, LAS unsigned char* lds, int l, int L, int logL) {
  const int tid = ltid();
  LDSF2* x = (LDSF2*)lds; LAS float* red = (LAS float*)(lds + LDS_MAIN);
  const v2f* TW = (const v2f*)(p.ws + OFF_TW);
  const int N = L;
  for (int it = blockIdx.x; it < 1024; it += gridDim.x) {
    v2f* kf = (v2f*)(p.ws + OFF_KF) + (size_t)it * N;
    __syncthreads();
    float s = 0.f;
    for (int m = tid; m < N; m += NTHR) { const v2f v = kf[m]; s += fabsf(v.x) + fabsf(v.y); x[PIDX(m)] = v; }
    const float S = block_sum(s, red);
    __syncthreads();
    fft_fwd(x, N, tid, NTHR, TW);
    const float invN = 1.0f / (float)N;
    spec_unpack(x, N, logL, kf, invN / (S + 1e-6f), p.hy_skip[l * 1024 + it] * invN, tid, NTHR, TW);
  }
  __syncthreads();
}

DEV void phase_lnmod(const Params& p, const Chunk& ck, int l) {
  const int tid_ = ltid(); const int lane = tid_ & 63, wv = (blockIdx.x * NTHR + tid_) >> 6, nw = gridDim.x * (NTHR / 64);
  const float* xin = (l == 0) ? ck.xin0 : ck.xout;
  bf16_t* H = (bf16_t*)(p.ws + OFF_H);
  const float* ada = (const float*)(p.ws + OFF_ADA) + (size_t)l * 6 * 3072;
#pragma unroll 2
  for (int r = wv; r < TCH; r += nw) {
    const float* xr = xin + (size_t)r * DM;
    f32x4 v[4]; float s = 0.f;
#pragma unroll
    for (int q = 0; q < 4; ++q) { v[q] = *(const f32x4*)(xr + q * 256 + lane * 4); s += v[q][0] + v[q][1] + v[q][2] + v[q][3]; }
    const float mu = wave_sum(s) * (1.0f / 1024.0f);
    float s2 = 0.f;
#pragma unroll
    for (int q = 0; q < 4; ++q) { v[q] -= mu; s2 += v[q][0] * v[q][0] + v[q][1] * v[q][1] + v[q][2] * v[q][2] + v[q][3] * v[q][3]; }
    const float rstd = rsqrtf(wave_sum(s2) * (1.0f / 1024.0f) + 1e-5f);
    const float* ar = ada + (size_t)(ck.bbase + r / ck.L) * 3072;
#pragma unroll
    for (int q = 0; q < 4; ++q) { const int c = q * 256 + lane * 4;
      const f32x4 sh = *(const f32x4*)(ar + c), scl = *(const f32x4*)(ar + 1024 + c);
      const f32x4 h = v[q] * rstd * (scl + 1.0f) + sh;
      u32x2 o; o[0] = pk2(h[0], h[1]); o[1] = pk2(h[2], h[3]);
      *(u32x2*)(H + (size_t)r * DM + c) = o; }
  }
}
DEV void phase_lnfinal(const Params& p, const Chunk& ck, int l) {
  const int tid_ = ltid(); const int lane = tid_ & 63, wv = (blockIdx.x * NTHR + tid_) >> 6, nw = gridDim.x * (NTHR / 64);
  const float* g = p.ln_g + l * DM; const float* b = p.ln_b + l * DM;
#pragma unroll 2
  for (int r = wv; r < TCH; r += nw) {
    float* xr = ck.xout + (size_t)r * DM;
    const bf16_t* rr = (const bf16_t*)(p.ws + OFF_RES) + (size_t)r * DM;
    f32x4 v[4]; float s = 0.f;
#pragma unroll
    for (int q = 0; q < 4; ++q) { const u32x2 w = *(const u32x2*)(rr + q * 256 + lane * 4);
      v[q][0] = bflo(w[0]); v[q][1] = bfhi(w[0]); v[q][2] = bflo(w[1]); v[q][3] = bfhi(w[1]); s += v[q][0] + v[q][1] + v[q][2] + v[q][3]; }
    const float mu = wave_sum(s) * (1.0f / 1024.0f);
    float s2 = 0.f;
#pragma unroll
    for (int q = 0; q < 4; ++q) { v[q] -= mu; s2 += v[q][0] * v[q][0] + v[q][1] * v[q][1] + v[q][2] * v[q][2] + v[q][3] * v[q][3]; }
    const float rstd = rsqrtf(wave_sum(s2) * (1.0f / 1024.0f) + 1e-5f);
#pragma unroll
    for (int q = 0; q < 4; ++q) { const int c = q * 256 + lane * 4;
      const f32x4 gv = *(const f32x4*)(g + c), bv = *(const f32x4*)(b + c);
      __builtin_nontemporal_store(v[q] * rstd * gv + bv, (f32x4*)(xr + c)); }
  }
}

DEV float shortconv(const bf16_t* u, int t, int L, float w0, float w1, float w2, float cb) {
  float a = fmaf(w1, bf2f(u[t]), cb);
  if (t > 0) a = fmaf(w0, bf2f(u[t - 1]), a);
  if (t + 1 < L) a = fmaf(w2, bf2f(u[t + 1]), a);
  return a;
}
DEV void hyena_item(const Params& p, LAS unsigned char* lds, const Chunk& ck, int l, int item) {
  const int tid = ltid();
  LDSF2* x = (LDSF2*)lds;
  const v2f* TW = (const v2f*)(p.ws + OFF_TW);
  const int L = ck.L, N = L, H = L >> 1;
  const int seq = item >> 9, ch = item & 511;
  const int tb = seq * L;
  const bf16_t* UT = (const bf16_t*)(p.ws + OFF_UT);
  const bf16_t* u0 = UT + (size_t)ch * TCH + tb; const bf16_t* u1 = UT + (size_t)(512 + ch) * TCH + tb; const bf16_t* u2 = UT + (size_t)(1024 + ch) * TCH + tb;
  const float* cw = p.hy_conv_w + (size_t)l * 3 * 1536; const float* cb = p.hy_conv_b + (size_t)l * 1536;
  const v2f* kf0 = (const v2f*)(p.ws + OFF_KF) + (size_t)ch * N; const v2f* kf1 = (const v2f*)(p.ws + OFF_KF) + (size_t)(512 + ch) * N;
  bf16_t* yT = (bf16_t*)(p.ws + OFF_YT) + (size_t)ch * TCH + tb;
  __syncthreads();
  { const float w0 = cw[ch], w1 = cw[1536 + ch], w2 = cw[3072 + ch], b = cb[ch];
    for (int m = tid; m < H; m += NTHR) { v2f v;
      v.x = shortconv(u0, 2 * m, L, w0, w1, w2, b); v.y = shortconv(u0, 2 * m + 1, L, w0, w1, w2, b);
      x[PIDX(m)] = v; } }
  __syncthreads();
  fft_fwd<true>(x, N, tid, NTHR, TW);
  spec_mul(x, N, ck.logL, kf0, tid, NTHR, TW);
  __syncthreads();
  fft_inv<true>(x, N, tid, NTHR, TW);
  { const float w0 = cw[512 + ch], w1 = cw[1536 + 512 + ch], w2 = cw[3072 + 512 + ch], b = cb[512 + ch];
    for (int m = tid; m < H; m += NTHR) { v2f v = x[PIDX(m)];
      v.x *= shortconv(u1, 2 * m, L, w0, w1, w2, b); v.y *= shortconv(u1, 2 * m + 1, L, w0, w1, w2, b);
      x[PIDX(m)] = v; } }
  __syncthreads();
  fft_fwd<true>(x, N, tid, NTHR, TW);
  spec_mul(x, N, ck.logL, kf1, tid, NTHR, TW);
  __syncthreads();
  fft_inv<true>(x, N, tid, NTHR, TW);
  { const float w0 = cw[1024 + ch], w1 = cw[1536 + 1024 + ch], w2 = cw[3072 + 1024 + ch], b = cb[1024 + ch];
    for (int m = tid; m < H; m += NTHR) { const v2f v = x[PIDX(m)];
      const float y0 = v.x * shortconv(u2, 2 * m, L, w0, w1, w2, b), y1 = v.y * shortconv(u2, 2 * m + 1, L, w0, w1, w2, b);
      *(unsigned*)(yT + 2 * m) = pk2(y0, y1); } }
}

DEV float qmax4(float v) { v = fmaxf(v, __shfl_xor(v, 16)); return fmaxf(v, __shfl_xor(v, 32)); }
DEV float qsum4(float v) { v += __shfl_xor(v, 16); return v + __shfl_xor(v, 32); }
DEV bf16x8 pack_p(const f32x4& a, const f32x4& b) {
  u32x4 r; r[0] = pk2(a[0], a[1]); r[1] = pk2(a[2], a[3]); r[2] = pk2(b[0], b[1]); r[3] = pk2(b[2], b[3]);
  return __builtin_bit_cast(bf16x8, r);
}
DEV bf16x8 gather_v(const bf16_t* vb, const int (&o0)[4], const int (&o1)[4], bool has1) {
  u32x4 r;
  r[0] = (unsigned)vb[o0[0]] | ((unsigned)vb[o0[1]] << 16); r[1] = (unsigned)vb[o0[2]] | ((unsigned)vb[o0[3]] << 16);
  if (has1) { r[2] = (unsigned)vb[o1[0]] | ((unsigned)vb[o1[1]] << 16); r[3] = (unsigned)vb[o1[2]] | ((unsigned)vb[o1[3]] << 16); }
  else { r[2] = 0u; r[3] = 0u; }
  return __builtin_bit_cast(bf16x8, r);
}

typedef short s16x4 __attribute__((ext_vector_type(4)));
constexpr int VT_STRIDE = 160, VT_TILE = 16 * VT_STRIDE;
DEV void stage_v(LAS unsigned char* wl, int tt, const bf16_t* vrow  , int c, int qd) {
  const u32x4 v0 = *(const u32x4*)vrow, v1 = *(const u32x4*)(vrow + 32);
  LAS unsigned char* d = wl + tt * VT_TILE + c * VT_STRIDE + 16 * qd;
  *(LAS u32x4*)d = v0; *(LAS u32x4*)(d + 64) = v1;
}
DEV bf16x8 read_vt(LAS unsigned char* wl, int nt, int c, int qd, bool has1) {
  LAS unsigned char* a = wl + (4 * qd + (c >> 2)) * VT_STRIDE + (16 * nt + 4 * (c & 3)) * 2;
  const s16x4 lo = __builtin_amdgcn_ds_read_tr16_b64_v4i16((LAS s16x4*)a);
  s16x4 hi = {0, 0, 0, 0};
  if (has1) hi = __builtin_amdgcn_ds_read_tr16_b64_v4i16((LAS s16x4*)(a + VT_TILE));
  bf16x8 r; r[0] = lo[0]; r[1] = lo[1]; r[2] = lo[2]; r[3] = lo[3]; r[4] = hi[0]; r[5] = hi[1]; r[6] = hi[2]; r[7] = hi[3];
  return r;
}

DEV void dil_wave(const Params& p, const Chunk& ck, int g, int tile, int h, LAS unsigned char* wl) {
  const int lane = ltid() & 63, c = lane & 15, qd = lane >> 4;
  const int logd = 2 * g, dl = 1 << logd;
  const int L = ck.L, Ld = L >> logd, tps = L >> 4;
  const int seq = tile / tps, tau = tile - seq * tps, j = tau & (dl - 1), a = tau >> logd;
  const int sb = seq * L;
  const bf16_t* P = (const bf16_t*)(p.ws + OFF_P);
  const int iq = 16 * a + c, tq = sb + iq * dl + j;
  const bf16_t* qp = P + (size_t)tq * PLD + COL_CQ + h * 64 + 8 * qd;
  const bf16x8 q0 = ld_frag(qp), q1 = ld_frag(qp + 32);
  f32x4 S[9]; int vtok[9];
  const int ib = 16 * a - 64;
#pragma unroll
  for (int kt = 0; kt < 9; ++kt) {
    const int ik = ib + 16 * kt + c; const int ikc = min(max(ik, 0), Ld - 1);
    const bf16_t* kp = P + (size_t)(sb + ikc * dl + j) * PLD + COL_CK + h * 64 + 8 * qd;
    f32x4 acc = {0.f, 0.f, 0.f, 0.f};
    acc = MFMA16(ld_frag(kp), q0, acc);
    acc = MFMA16(ld_frag(kp + 32), q1, acc);
#pragma unroll
    for (int jj = 0; jj < 4; ++jj) { const int i2 = ib + 16 * kt + 4 * qd + jj; const int df = i2 - iq;
      const bool ok = (i2 >= 0) && (i2 < Ld) && (df <= 64) && (df >= -64);
      acc[jj] = ok ? acc[jj] * 0.125f : -1e30f; }
    vtok[kt] = sb + ikc * dl + j;
    S[kt] = acc;
  }
  float mx = -1e30f;
#pragma unroll
  for (int kt = 0; kt < 9; ++kt) mx = fmaxf(mx, fmaxf(fmaxf(S[kt][0], S[kt][1]), fmaxf(S[kt][2], S[kt][3])));
  mx = qmax4(mx);
  float ls = 0.f;
#pragma unroll
  for (int kt = 0; kt < 9; ++kt) {
#pragma unroll
    for (int jj = 0; jj < 4; ++jj) { const float e = __expf(S[kt][jj] - mx); S[kt][jj] = e; ls += e; } }
  ls = qsum4(ls);
  f32x4 O[4];
#pragma unroll
  for (int nt = 0; nt < 4; ++nt) O[nt] = (f32x4){0.f, 0.f, 0.f, 0.f};
  const f32x4 zero4 = {0.f, 0.f, 0.f, 0.f};
#pragma unroll
  for (int pr = 0; pr < 5; ++pr) {
    const bool has1 = (pr < 4);
    const bf16x8 pf = pack_p(S[2 * pr], has1 ? S[has1 ? 2 * pr + 1 : 0] : zero4);
    stage_v(wl, 0, P + (size_t)vtok[2 * pr] * PLD + COL_CV + h * 64 + 8 * qd, c, qd);
    if (has1) stage_v(wl, 1, P + (size_t)vtok[has1 ? 2 * pr + 1 : 0] * PLD + COL_CV + h * 64 + 8 * qd, c, qd);
#pragma unroll
    for (int nt = 0; nt < 4; ++nt) {
      const bf16x8 vf = read_vt(wl, nt, c, qd, has1);
      O[nt] = MFMA16(vf, pf, O[nt]);
    }
  }
  const float inv = 1.0f / ls;
  bf16_t* dp = (bf16_t*)(p.ws + OFF_DP) + ((size_t)g * TCH + tq) * 256 + h * 64 + 4 * qd;
#pragma unroll
  for (int nt = 0; nt < 4; ++nt) { const f32x4 ov = O[nt] * inv; u32x2 o; o[0] = pk2(ov[0], ov[1]); o[1] = pk2(ov[2], ov[3]); *(u32x2*)(dp + 16 * nt) = o; }
  if (qd == 0) ((float*)(p.ws + OFF_LSE))[((size_t)g * TCH + tq) * 4 + h] = mx + __logf(ls);
}

DEV void na_wave(const Params& p, const Chunk& ck, int l, int tile, int h, LAS unsigned char* wl) {
  const int lane = ltid() & 63, c = lane & 15, qd = lane >> 4;
  const int L = ck.L, rows = L >> 6;
  const int t0 = tile * 16, seq = t0 / L, pos0 = t0 & (L - 1), r = pos0 >> 6, c0 = pos0 & 63;
  const int rs = min(max(r - 4, 0), rows - 8), cb = min(max(c0 - 8, 0), 32);
  const int cq = c0 + c, csq = min(max(cq - 8, 0), 48);
  bf16_t* P = (bf16_t*)(p.ws + OFF_P);
  const float* rpb = p.na_rpb + (size_t)(l * 4 + h) * 15 * 31;
  const int tq = t0 + c;
  const bf16_t* qp = P + (size_t)tq * PLD + COL_BQ + h * 64 + 8 * qd;
  const bf16x8 q0 = ld_frag(qp), q1 = ld_frag(qp + 32);
  const int kbase = seq * L + rs * 64 + cb;
  f32x4 S[16];
#pragma unroll
  for (int kt = 0; kt < 16; ++kt) {
    const int i = kt >> 1, hf = kt & 1;
    const bf16_t* kp = P + (size_t)(kbase + i * 64 + hf * 16 + c) * PLD + COL_BK + h * 64 + 8 * qd;
    f32x4 acc = {0.f, 0.f, 0.f, 0.f};
    acc = MFMA16(ld_frag(kp), q0, acc);
    acc = MFMA16(ld_frag(kp + 32), q1, acc);
    const float* rp = rpb + (rs + i - r + 7) * 31;
#pragma unroll
    for (int jj = 0; jj < 4; ++jj) { const int colk = cb + hf * 16 + 4 * qd + jj;
      const bool ok = (colk >= csq) && (colk < csq + 16);
      const int dc = min(max(colk - cq, -15), 15) + 15;
      acc[jj] = ok ? acc[jj] * 0.125f + rp[dc] : -1e30f; }
    S[kt] = acc;
  }
  float mx = -1e30f;
#pragma unroll
  for (int kt = 0; kt < 16; ++kt) mx = fmaxf(mx, fmaxf(fmaxf(S[kt][0], S[kt][1]), fmaxf(S[kt][2], S[kt][3])));
  mx = qmax4(mx);
  float ls = 0.f;
#pragma unroll
  for (int kt = 0; kt < 16; ++kt) {
#pragma unroll
    for (int jj = 0; jj < 4; ++jj) { const float e = __expf(S[kt][jj] - mx); S[kt][jj] = e; ls += e; } }
  ls = qsum4(ls);
  f32x4 O[4];
#pragma unroll
  for (int nt = 0; nt < 4; ++nt) O[nt] = (f32x4){0.f, 0.f, 0.f, 0.f};
#pragma unroll
  for (int i = 0; i < 8; ++i) {
    const bf16x8 pf = pack_p(S[2 * i], S[2 * i + 1]);
    const bf16_t* vr = P + (size_t)(kbase + i * 64 + c) * PLD + COL_BV + h * 64 + 8 * qd;
    stage_v(wl, 0, vr, c, qd); stage_v(wl, 1, vr + (size_t)16 * PLD, c, qd);
#pragma unroll
    for (int nt = 0; nt < 4; ++nt) {
      const bf16x8 vf = read_vt(wl, nt, c, qd, true);
      O[nt] = MFMA16(vf, pf, O[nt]);
    }
  }
  const float inv = 1.0f / ls;
  bf16_t* zp = P + (size_t)tq * PLD + COL_BZ + h * 64 + 4 * qd;
#pragma unroll
  for (int nt = 0; nt < 4; ++nt) { const u32x2 z = *(const u32x2*)(zp + 16 * nt); u32x2 o;
    o[0] = pk2(O[nt][0] * inv * bflo(z[0]), O[nt][1] * inv * bfhi(z[0]));
    o[1] = pk2(O[nt][2] * inv * bflo(z[1]), O[nt][3] * inv * bfhi(z[1]));
    *(u32x2*)(zp + 16 * nt) = o; }
}

DEV void dil_item(const Params& p, LAS unsigned char* lds, const Chunk& ck, int item) {
  const int wave = __builtin_amdgcn_readfirstlane(ltid() >> 6);
  const int g = item >> 9, wi = (item & 511) * 8 + wave;
  dil_wave(p, ck, g, wi >> 2, wi & 3, lds + wave * (2 * VT_TILE));
}
DEV void na_item(const Params& p, LAS unsigned char* lds, const Chunk& ck, int l, int item) {
  const int wave = __builtin_amdgcn_readfirstlane(ltid() >> 6);
  const int wi = item * 8 + wave;
  na_wave(p, ck, l, wi >> 2, wi & 3, lds + wave * (2 * VT_TILE));
}

DEV void phase_mixers(const Params& p, LAS unsigned char* lds, const Chunk& ck, int l) {
  unsigned* ctr = (unsigned*)(p.ws + OFF_CTR) + (l * 4 + ck.c);
  LAS int* slot = (LAS int*)(lds + LDS_MAIN + 512);
  const int nd = 3 * 512, nn = 512, nh = ck.nseq * 512;
  const int total = nd + nn + nh;
  for (;;) {
    __syncthreads();
    if (ltid() == 0) *slot = (int)atomicAdd(ctr, 1u);
    __syncthreads();
    const int it = *slot;
    if (it >= total) break;
    if (it < nh) { if (SEN(2)) hyena_item(p, lds, ck, l, it); }
    else if (it < nh + nn) { if (SEN(1)) na_item(p, lds, ck, l, it - nh); }
    else { if (SEN(0)) dil_item(p, lds, ck, it - nh - nn); }
  }
}

DEV void phase_ygate(const Params& p, LAS unsigned char* lds) {
  const int tid = ltid();
  {
    bf16_t* Pm = (bf16_t*)(p.ws + OFF_P);
    const bf16_t* DP = (const bf16_t*)(p.ws + OFF_DP); const float* LSE = (const float*)(p.ws + OFF_LSE);
#pragma unroll 2
    for (int i = blockIdx.x * NTHR + tid; i < TCH * 32; i += gridDim.x * NTHR) {
      const int tok = i >> 5, d8 = (i & 31) * 8, h = d8 >> 6;
      const float l0 = LSE[(size_t)tok * 4 + h], l1 = LSE[((size_t)TCH + tok) * 4 + h], l2 = LSE[((size_t)2 * TCH + tok) * 4 + h];
      const float lm = fmaxf(l0, fmaxf(l1, l2));
      float w0 = __expf(l0 - lm), w1 = __expf(l1 - lm), w2 = __expf(l2 - lm);
      const float wi = 1.0f / (w0 + w1 + w2); w0 *= wi; w1 *= wi; w2 *= wi;
      const bf16_t* a0 = DP + (size_t)tok * 256 + d8; const bf16_t* a1 = a0 + (size_t)TCH * 256; const bf16_t* a2 = a1 + (size_t)TCH * 256;
      const u32x4 q0 = *(const u32x4*)a0, q1 = *(const u32x4*)a1, q2 = *(const u32x4*)a2;
      f32x4 x0, x1;
      x0[0] = bflo(q0[0]) * w0 + bflo(q1[0]) * w1 + bflo(q2[0]) * w2; x0[1] = bfhi(q0[0]) * w0 + bfhi(q1[0]) * w1 + bfhi(q2[0]) * w2;
      x0[2] = bflo(q0[1]) * w0 + bflo(q1[1]) * w1 + bflo(q2[1]) * w2; x0[3] = bfhi(q0[1]) * w0 + bfhi(q1[1]) * w1 + bfhi(q2[1]) * w2;
      x1[0] = bflo(q0[2]) * w0 + bflo(q1[2]) * w1 + bflo(q2[2]) * w2; x1[1] = bfhi(q0[2]) * w0 + bfhi(q1[2]) * w1 + bfhi(q2[2]) * w2;
      x1[2] = bflo(q0[3]) * w0 + bflo(q1[3]) * w1 + bflo(q2[3]) * w2; x1[3] = bfhi(q0[3]) * w0 + bfhi(q1[3]) * w1 + bfhi(q2[3]) * w2;
      bf16_t* zp = Pm + (size_t)tok * PLD + COL_CZ + d8;
      const u32x4 z = *(const u32x4*)zp; u32x4 o;
      o[0] = pk2(x0[0] * bflo(z[0]), x0[1] * bfhi(z[0])); o[1] = pk2(x0[2] * bflo(z[1]), x0[3] * bfhi(z[1]));
      o[2] = pk2(x1[0] * bflo(z[2]), x1[1] * bfhi(z[2])); o[3] = pk2(x1[2] * bflo(z[3]), x1[3] * bfhi(z[3]));
      *(u32x4*)zp = o;
    }
  }
  LAS bf16_t* tile = (LAS bf16_t*)lds;
  const bf16_t* yT = (const bf16_t*)(p.ws + OFF_YT);
  bf16_t* P = (bf16_t*)(p.ws + OFF_P);
  for (int it = blockIdx.x; it < 8 * (TCH / 64); it += gridDim.x) {
    const int ch0 = (it & 7) * 64, t0 = (it >> 3) * 64;
    __syncthreads();
    { const int i = tid >> 3, j8 = (tid & 7) * 8;
      const u32x4 v = *(const u32x4*)(yT + (size_t)(ch0 + i) * TCH + t0 + j8);
      *(LAS u32x4*)(tile + i * 72 + j8) = v; }
    __syncthreads();
    { const int t = tid >> 3, c8 = (tid & 7) * 8;
      bf16_t* zp = P + (size_t)(t0 + t) * PLD + COL_AZ + ch0 + c8;
      const u32x4 z = *(const u32x4*)zp; u32x4 r;
      float y[8];
#pragma unroll
      for (int q = 0; q < 8; ++q) y[q] = bf2f(tile[(c8 + q) * 72 + t]);
      r[0] = pk2(y[0] * bflo(z[0]), y[1] * bfhi(z[0])); r[1] = pk2(y[2] * bflo(z[1]), y[3] * bfhi(z[1]));
      r[2] = pk2(y[4] * bflo(z[2]), y[5] * bfhi(z[2])); r[3] = pk2(y[6] * bflo(z[3]), y[7] * bfhi(z[3]));
      *(u32x4*)zp = r; }
  }
}

#ifndef ONLY
#define ONLY -1
#endif
#define EN(k) (ONLY < 0 || ONLY == (k))
#define XB_TMO      128
#define XB_XCNT(j)  (256  + 64 * (j))
#define XB_XSUB(j)  (1280 + 64 * (j))
#define XB_XGEN(j)  (2304 + 64 * (j))
#define XB_TOP      3328
#define XB_TOPGEN   3392
#define XCD_BAR_WORDS 3456
#define XB_SPIN_CAP (1u << 18)
DEV unsigned xb_ld(unsigned* p)              { return __hip_atomic_load(p, __ATOMIC_RELAXED, __HIP_MEMORY_SCOPE_AGENT); }
DEV unsigned xb_add(unsigned* p, unsigned v) { return __hip_atomic_fetch_add(p, v, __ATOMIC_RELAXED, __HIP_MEMORY_SCOPE_AGENT); }
DEV unsigned xb_xcc_id() { return (unsigned)__builtin_amdgcn_s_getreg((3 << 11) | 20) & 0xFu; }
#define XB_SPIN(cond, bar) do { unsigned _sp = 0; while (cond) { __builtin_amdgcn_s_sleep(1); \
    if ((++_sp & 255u) == 0u) { if (xb_ld(&(bar)[XB_TMO])) break; if (_sp > XB_SPIN_CAP) { atomicAdd(&(bar)[XB_TMO], 1u); break; } } } } while (0)
struct XcdBarrier { unsigned* bar; unsigned x; volatile LAS unsigned* st; };
DEV XcdBarrier xcd_barrier_post(unsigned* bar, volatile LAS unsigned* st) {
  XcdBarrier b; b.bar = bar; b.x = xb_xcc_id(); b.st = st;
  if (threadIdx.x == 0) (void)xb_add(&bar[XB_XCNT(b.x)], 1u);
  return b;
}
DEV void xcd_barrier_complete(unsigned* bar, unsigned x, unsigned& nloc, unsigned& nx) {
  const unsigned G = gridDim.x * gridDim.y * gridDim.z;
  unsigned sum, cnt, mine, sp = 0u;
  for (;;) {
    sum = 0u; cnt = 0u; mine = 0u;
#pragma unroll
    for (unsigned j = 0; j < 16; ++j) { const unsigned c = xb_ld(&bar[XB_XCNT(j)]); sum += c; cnt += (c > 0u) ? 1u : 0u; mine = (j == x) ? c : mine; }
    if (sum == G) break;
    __builtin_amdgcn_s_sleep(1);
    if ((++sp & 255u) == 0u) { if (xb_ld(&bar[XB_TMO])) break; if (sp > XB_SPIN_CAP) { atomicAdd(&bar[XB_TMO], 1u); break; } }
  }
  nloc = mine > 0u ? mine : 1u; nx = cnt > 0u ? cnt : 1u;
}
DEV void xcd_barrier(const XcdBarrier& b) {
  asm volatile("s_waitcnt vmcnt(0)" ::: "memory");
  __syncthreads();
  if (threadIdx.x == 0) {
    unsigned* bar = b.bar;
    __builtin_amdgcn_s_waitcnt(0);
    unsigned nloc = b.st[0], nx = b.st[1];
    if (nloc == 0u) { xcd_barrier_complete(bar, b.x, nloc, nx); b.st[0] = nloc; b.st[1] = nx; }
    const unsigned old = xb_add(&bar[XB_XSUB(b.x)], 1u);
    const unsigned gen = old / nloc;
    if (old + 1u == (gen + 1u) * nloc) {
      __builtin_amdgcn_fence(__ATOMIC_RELEASE, "agent");
      asm volatile("s_waitcnt vmcnt(0)" ::: "memory");
      const unsigned og = xb_add(&bar[XB_TOP], 1u);
      const unsigned tg = og / nx;
      if (og + 1u == (tg + 1u) * nx) xb_add(&bar[XB_TOPGEN], 1u);
      else XB_SPIN(xb_ld(&bar[XB_TOPGEN]) == tg, bar);
      __builtin_amdgcn_fence(__ATOMIC_ACQUIRE, "agent");
      xb_add(&bar[XB_XGEN(b.x)], 1u);
      asm volatile("s_waitcnt vmcnt(0)" ::: "memory");
    } else {
      XB_SPIN(xb_ld(&bar[XB_XGEN(b.x)]) == gen, bar);
      __builtin_amdgcn_fence(__ATOMIC_ACQUIRE, "agent");
      asm volatile("s_waitcnt vmcnt(0)" ::: "memory");
    }
  }
  __syncthreads();
}

constexpr int NPHASES = 50;
DEV void run_phase(const Params& p, LAS unsigned char* lds, int ph) {
  if (ph == 0) { if (EN(0)) phase0(p, lds); return; }
  const int idx = ph - 1;
  if (idx == 48) { const Chunk ck = make_chunk(p, 3); if (EN(9)) phase_lnfinal(p, ck, 1); return; }
  const int l = idx / 24, c = (idx % 24) / 6, s = idx % 6;
  const Chunk ck = make_chunk(p, c);
  bf16_t* H = (bf16_t*)(p.ws + OFF_H); bf16_t* P = (bf16_t*)(p.ws + OFF_P);
  switch (s) {
    case 0: {
      if (!(l == 0 && c == 0)) { const int pl = (c == 0) ? l - 1 : l, pc = (c == 0) ? 3 : c - 1; const Chunk pk = make_chunk(p, pc); if (EN(9)) phase_lnfinal(p, pk, pl); }
      if (EN(3)) phase_lnmod(p, ck, l);
      if (c == 0) { if (EN(1)) phase_fa(p, lds, l, 8192); } else if (c == 2) { if (EN(1)) phase_fa(p, lds, l, 16384); }
    } break;
    case 1: if (EN(4)) { pg8::Gemm g{H, (const bf16_t*)(p.ws + OFF_WIN) + (size_t)l * NIN * DM, DM, DM, TCH, NIN, DM};
      EpiIn E{(const float*)(p.ws + OFF_BIAS) + l * NIN, (bf16_t*)(p.ws + OFF_UT), P, (const f32x4*)(p.ws + OFF_ROPE), ck.L};
      pg8::PlainSched S; S.init(g, gridDim.x, blockIdx.x); pg8::gemm_phase(lds, DM, DM, S, E); }
      if (c == 0) { if (EN(2)) phase_fb(p, lds, l, 8192, 13); } else if (c == 2) { if (EN(2)) phase_fb(p, lds, l, 16384, 14); }
      break;
    case 2: if (EN(5)) phase_mixers(p, lds, ck, l); break;
    case 3: if (EN(6)) phase_ygate(p, lds); break;
    case 4: if (EN(7)) { pg8::BranchSched S; S.init(P, (const bf16_t*)(p.ws + OFF_WA) + (size_t)l * DM * DM, gridDim.x, blockIdx.x);
      EpiBranch E{P, H}; pg8::gemm_phase(lds, PLD, DM, S, E); } break;
    default: if (EN(8)) { pg8::Gemm g{H, (const bf16_t*)(p.ws + OFF_WO) + (size_t)l * DM * DM, DM, DM, TCH, DM, DM};
      EpiOut E{(l == 0) ? ck.xin0 : ck.xout, (bf16_t*)(p.ws + OFF_RES), (const float*)(p.ws + OFF_ADA) + (size_t)l * 6 * 3072, ck.bbase, ck.L};
      pg8::PlainSched S; S.init(g, gridDim.x, blockIdx.x); pg8::gemm_phase(lds, DM, DM, S, E); } break;
  }
}

__global__ void __launch_bounds__(512, 2) fwd_megakernel(Params p) {
  extern __shared__ __attribute__((aligned(16))) unsigned char shm[];
  LAS unsigned char* lds = (LAS unsigned char*)shm;
  cg::grid_group grid = cg::this_grid();
  volatile LAS unsigned* stw = (volatile LAS unsigned*)(lds + LDS_MAIN + 768);
  if (threadIdx.x == 0) { stw[0] = 0u; stw[1] = 0u; }
  __syncthreads();
  const XcdBarrier xb = xcd_barrier_post((unsigned*)(p.ws + OFF_BAR), stw);
  for (int ph = p.ph_begin; ph < p.ph_end; ++ph) {
    Params q = p; asm volatile("" : "+s"(q.ws), "+s"(q.out));
    run_phase(q, lds, ph);
    if (ph + 1 < p.ph_end) { if (p.ph_begin < 0) grid.sync(); else xcd_barrier(xb); }
  }
}

extern "C" void kernel_launch(void* const* d_in, const int* in_sizes, int n_in, void* d_out, int out_size, void* d_ws, size_t ws_size, hipStream_t stream) {
  (void)in_sizes; (void)n_in; (void)out_size;
  static int grid_blocks = 0;
  if (!grid_blocks) {
    int dev = 0, cus = 0, per_cu = 0;
    hipGetDevice(&dev);
    hipDeviceGetAttribute(&cus, hipDeviceAttributeMultiprocessorCount, dev);
    hipFuncSetAttribute((const void*)fwd_megakernel, hipFuncAttributeMaxDynamicSharedMemorySize, LDS_TOTAL);
    hipOccupancyMaxActiveBlocksPerMultiprocessor(&per_cu, fwd_megakernel, NTHR, LDS_TOTAL);
    if (per_cu < 1) per_cu = 1;
    grid_blocks = cus * per_cu;
  }
  if (ws_size < WS_NEED) { fprintf(stderr, "workspace too small: %zu < %zu\n", ws_size, (size_t)WS_NEED); return; }
  Params p{};
  p.x_prompt = (const float*)d_in[0]; p.x_sample = (const float*)d_in[1]; p.c_prompt = (const float*)d_in[2]; p.c_sample = (const float*)d_in[3];
  p.w_ada = (const float*)d_in[4]; p.b_ada = (const float*)d_in[5]; p.w_in = (const float*)d_in[6]; p.b_in = (const float*)d_in[7];
  p.hy_conv_w = (const float*)d_in[8]; p.hy_conv_b = (const float*)d_in[9]; p.hy_w1 = (const float*)d_in[10]; p.hy_b1 = (const float*)d_in[11];
  p.hy_freq = (const float*)d_in[12]; p.hy_w2 = (const float*)d_in[13]; p.hy_b2 = (const float*)d_in[14]; p.hy_w3 = (const float*)d_in[15];
  p.hy_b3 = (const float*)d_in[16]; p.hy_decay = (const float*)d_in[17]; p.hy_skip = (const float*)d_in[18]; p.na_rpb = (const float*)d_in[19];
  p.w_br_a = (const float*)d_in[20]; p.w_br_b = (const float*)d_in[21]; p.w_br_c = (const float*)d_in[22]; p.w_out = (const float*)d_in[23];
  p.ln_g = (const float*)d_in[24]; p.ln_b = (const float*)d_in[25];
  p.out = (float*)d_out; p.ws = (unsigned char*)d_ws;
  (void)hipMemsetAsync((unsigned char*)d_ws + OFF_BAR, 0, 16384, stream);
#if MULTI_LAUNCH
  for (int ph = 0; ph < NPHASES; ++ph) { p.ph_begin = ph; p.ph_end = ph + 1;
    hipLaunchKernelGGL(fwd_megakernel, dim3(grid_blocks), dim3(NTHR), LDS_TOTAL, stream, p); }
#else
  p.ph_begin = 0; p.ph_end = NPHASES;
  void* args[] = {&p};
  hipError_t e = hipLaunchCooperativeKernel((const void*)fwd_megakernel, dim3(grid_blocks), dim3(NTHR), args, LDS_TOTAL, stream);
  if (e != hipSuccess) fprintf(stderr, "cooperative launch failed: %s (grid %d)\n", hipGetErrorString(e), grid_blocks);
#endif
}
```
